# Optimizing an MI355X kernel written in HIP

```python
import math
import jax, jax.numpy as jnp
from jax import lax
import numpy as np

D_MODEL = 2048
BATCH = 16
SEQ = 256
DEPTH = 2
DEC_BATCH = 2
DEC_SEQ = 2048
PAST_LEN = 256

GRID_W = 64
N_MIXERS = 2
N_A_LAYERS = (DEPTH + N_MIXERS - 1) // N_MIXERS
N_B_LAYERS = DEPTH // N_MIXERS
N_SUB = 3
A_HEAD_DIM = 128
A_HEADS = D_MODEL // A_HEAD_DIM
A_KV_HEADS = 4
B_QK_DIM = 64
B_V_DIM = 2 * B_QK_DIM
B_HEADS = D_MODEL // B_V_DIM
D_FF = ((8 * D_MODEL // 3 + 127) // 128) * 128
ROPE_THETA = 10000.0
Q_BLOCK = 128
EPS = 1e-6
MACARON_WEIGHT = 0.5
DEEPNORM_ALPHA = (2 * DEPTH) ** 0.25
DEEPNORM_BETA = (8 * DEPTH) ** -0.25

kernel_name = "hybrid_diffusion_gqa_diffattn_macaron_step"


def layer_norm(x, g, b):
    xf = x.astype(jnp.float32)
    mu = jnp.mean(xf, -1, keepdims=True)
    xc = xf - mu
    var = jnp.mean(xc * xc, -1, keepdims=True)
    return (xc * lax.rsqrt(var + EPS) * g + b).astype(x.dtype)


def rms_norm(x, g):
    xf = x.astype(jnp.float32)
    return (xf * lax.rsqrt(jnp.mean(xf * xf, -1, keepdims=True) + EPS) * g).astype(x.dtype)


def modulation(cond, w, b):
    m = jax.nn.silu(cond) @ w + b
    return m.reshape(cond.shape[0], N_SUB, 3, D_MODEL)


def modulate(x, m, s):
    shift = m[:, s, 0][:, None, :]
    scale = m[:, s, 1][:, None, :]
    gate = m[:, s, 2][:, None, :]
    return x * (1 + scale) + shift, gate


def post_norm(x, out, g, b):
    return layer_norm(DEEPNORM_ALPHA * x + out, g, b)


def swiglu(h, w_in, w_out):
    gu = h @ w_in
    g, u = jnp.split(gu, 2, axis=-1)
    return (jax.nn.silu(g) * u) @ w_out


def ffn_sublayer(x, m, s, w_in, w_out, g, b):
    h, gate = modulate(x, m, s)
    return post_norm(x, MACARON_WEIGHT * gate * swiglu(h, w_in, w_out), g, b)


def axial_rope(rows, dim):
    row = jnp.repeat(jnp.arange(rows, dtype=jnp.float32), GRID_W)
    col = jnp.tile(jnp.arange(GRID_W, dtype=jnp.float32), rows)
    quarter = dim // 4
    inv = ROPE_THETA ** (-jnp.arange(quarter, dtype=jnp.float32) / quarter)
    ang = jnp.concatenate([row[:, None] * inv, col[:, None] * inv], axis=-1)
    return jnp.cos(ang), jnp.sin(ang)


def apply_rope(x, cos, sin):
    shp = (cos.shape[0],) + (1,) * (x.ndim - 3) + (cos.shape[-1],)
    cos = cos.reshape(shp)
    sin = sin.reshape(shp)
    xf = x.astype(jnp.float32)
    half = x.shape[-1] // 2
    x1, x2 = xf[..., :half], xf[..., half:]
    return jnp.concatenate([x1 * cos - x2 * sin, x2 * cos + x1 * sin], axis=-1).astype(x.dtype)


def split_query_blocks(q):
    bsz, s = q.shape[0], q.shape[1]
    return q.reshape(bsz, s // Q_BLOCK, Q_BLOCK, *q.shape[2:]).swapaxes(0, 1)


def merge_query_blocks(o):
    nb, bsz, qb = o.shape[0], o.shape[1], o.shape[2]
    return o.swapaxes(0, 1).reshape(bsz, nb * qb, *o.shape[3:])


def gqa_attention(q, k, v):
    bsz, s, h, d = q.shape
    kvh = k.shape[2]
    qg = q.reshape(bsz, s, kvh, h // kvh, d)
    scale = d ** -0.5

    def block(qb):
        sc = jnp.einsum('bqhgd,bkhd->bhgqk', qb, k).astype(jnp.float32) * scale
        p = jax.nn.softmax(sc, axis=-1).astype(v.dtype)
        return jnp.einsum('bhgqk,bkhd->bqhgd', p, v)

    o = lax.map(block, split_query_blocks(qg))
    return merge_query_blocks(o).reshape(bsz, s, h * d)


def diff_attention(q, k, v, lam):
    scale = q.shape[-1] ** -0.5

    def block(qb):
        sc = jnp.einsum('bqhcd,bkhcd->cbhqk', qb, k).astype(jnp.float32) * scale
        p = jax.nn.softmax(sc, axis=-1)
        w = (p[0] - lam * p[1]).astype(v.dtype)
        return jnp.einsum('bhqk,bkhd->bqhd', w, v)

    o = lax.map(block, split_query_blocks(q))
    return merge_query_blocks(o)


def mixer_a_qkv(h, w_qkv, qn, kn):
    bsz, s, _ = h.shape
    qkv = h @ w_qkv
    q, k, v = jnp.split(qkv, [A_HEADS * A_HEAD_DIM, (A_HEADS + A_KV_HEADS) * A_HEAD_DIM], axis=-1)
    q = rms_norm(q.reshape(bsz, s, A_HEADS, A_HEAD_DIM), qn)
    k = rms_norm(k.reshape(bsz, s, A_KV_HEADS, A_HEAD_DIM), kn)
    v = v.reshape(bsz, s, A_KV_HEADS, A_HEAD_DIM)
    return q, k, v


def mixer_b_qkv(h, w_qkv):
    bsz, s, _ = h.shape
    qk_w = B_HEADS * 2 * B_QK_DIM
    q, k, v = jnp.split(h @ w_qkv, [qk_w, 2 * qk_w], axis=-1)
    q = q.reshape(bsz, s, B_HEADS, 2, B_QK_DIM)
    k = k.reshape(bsz, s, B_HEADS, 2, B_QK_DIM)
    v = v.reshape(bsz, s, B_HEADS, B_V_DIM)
    return q, k, v


def diff_lambda_init(layer_idx):
    return 0.8 - 0.6 * math.exp(-0.3 * layer_idx)


def diff_lambda(lam_p, lambda_init):
    lp = lam_p.astype(jnp.float32)
    return jnp.exp(jnp.sum(lp[0] * lp[1])) - jnp.exp(jnp.sum(lp[2] * lp[3])) + lambda_init


def diff_output(o, subln_g, lambda_init, w_o):
    bsz, s = o.shape[0], o.shape[1]
    o = rms_norm(o, subln_g) * (1.0 - lambda_init)
    return o.reshape(bsz, s, B_HEADS * B_V_DIM) @ w_o


def setup_inputs(seed: int = 0) -> dict:
    key = jax.random.key(seed)
    ks = jax.random.split(key, 24)
    f32 = jnp.float32
    nrm = lambda k, shp, sc: jax.random.normal(k, shp, f32) * sc
    qkv_a_w = (A_HEADS + 2 * A_KV_HEADS) * A_HEAD_DIM
    qkv_b_w = 2 * B_HEADS * 2 * B_QK_DIM + B_HEADS * B_V_DIM
    return {
        "x_prompt": nrm(ks[0], (BATCH, SEQ, D_MODEL), 1.0),
        "x_sample": nrm(ks[1], (DEC_BATCH, DEC_SEQ, D_MODEL), 1.0),
        "cache_a_k": nrm(ks[2], (DEC_BATCH, N_A_LAYERS, PAST_LEN, A_KV_HEADS, A_HEAD_DIM), 1.0),
        "cache_a_v": nrm(ks[3], (DEC_BATCH, N_A_LAYERS, PAST_LEN, A_KV_HEADS, A_HEAD_DIM), 1.0),
        "cache_b_k": nrm(ks[4], (DEC_BATCH, N_B_LAYERS, PAST_LEN, B_HEADS, 2, B_QK_DIM), 1.0),
        "cache_b_v": nrm(ks[5], (DEC_BATCH, N_B_LAYERS, PAST_LEN, B_HEADS, B_V_DIM), 1.0),
        "c": nrm(ks[6], (DEC_BATCH, D_MODEL), 1.0),
        "c_ctx": nrm(ks[7], (D_MODEL,), 1.0),
        "ada_w": nrm(ks[8], (DEPTH, D_MODEL, N_SUB * 3 * D_MODEL), 0.5 * D_MODEL ** -0.5),
        "ada_b": nrm(ks[9], (DEPTH, N_SUB * 3 * D_MODEL), 0.01),
        "ln_g": 1.0 + nrm(ks[10], (DEPTH, N_SUB, D_MODEL), 0.01),
        "ln_b": nrm(ks[11], (DEPTH, N_SUB, D_MODEL), 0.01),
        "ffn_w_in": nrm(ks[12], (DEPTH, 2, D_MODEL, 2 * D_FF), D_MODEL ** -0.5),
        "ffn_w_out": nrm(ks[13], (DEPTH, 2, D_FF, D_MODEL), DEEPNORM_BETA * D_FF ** -0.5),
        "a_w_qkv": nrm(ks[14], (N_A_LAYERS, D_MODEL, qkv_a_w), D_MODEL ** -0.5),
        "a_q_norm": 1.0 + nrm(ks[15], (N_A_LAYERS, A_HEAD_DIM), 0.01),
        "a_k_norm": 1.0 + nrm(ks[16], (N_A_LAYERS, A_HEAD_DIM), 0.01),
        "a_w_o": nrm(ks[17], (N_A_LAYERS, A_HEADS * A_HEAD_DIM, D_MODEL), DEEPNORM_BETA * (A_HEADS * A_HEAD_DIM) ** -0.5),
        "b_w_qkv": nrm(ks[18], (N_B_LAYERS, D_MODEL, qkv_b_w), D_MODEL ** -0.5),
        "b_lambda": nrm(ks[19], (N_B_LAYERS, 4, B_QK_DIM), 0.1),
        "b_subln": 1.0 + nrm(ks[20], (N_B_LAYERS, B_V_DIM), 0.01),
        "b_w_o": nrm(ks[21], (N_B_LAYERS, B_HEADS * B_V_DIM, D_MODEL), DEEPNORM_BETA * (B_HEADS * B_V_DIM) ** -0.5),
    }


def reference(x_prompt, x_sample, cache_a_k, cache_a_v, cache_b_k, cache_b_v, c, c_ctx,
              ada_w, ada_b, ln_g, ln_b, ffn_w_in, ffn_w_out,
              a_w_qkv, a_q_norm, a_k_norm, a_w_o,
              b_w_qkv, b_lambda, b_subln, b_w_o):
    x = x_prompt
    new_a_k, new_a_v, new_b_k, new_b_v = [], [], [], []
    for i in range(DEPTH):
        j = i // N_MIXERS
        m = modulation(c_ctx[None, :], ada_w[i], ada_b[i])
        x = ffn_sublayer(x, m, 0, ffn_w_in[i, 0], ffn_w_out[i, 0], ln_g[i, 0], ln_b[i, 0])
        h, gate = modulate(x, m, 1)
        if i % N_MIXERS == 0:
            q, k, v = mixer_a_qkv(h, a_w_qkv[j], a_q_norm[j], a_k_norm[j])
            y = gqa_attention(q, k, v) @ a_w_o[j]
            new_a_k.append(k)
            new_a_v.append(v)
        else:
            lam_init = diff_lambda_init(i)
            q, k, v = mixer_b_qkv(h, b_w_qkv[j])
            o = diff_attention(q, k, v, diff_lambda(b_lambda[j], lam_init))
            y = diff_output(o, b_subln[j], lam_init, b_w_o[j])
            new_b_k.append(k)
            new_b_v.append(v)
        x = post_norm(x, gate * y, ln_g[i, 1], ln_b[i, 1])
        x = ffn_sublayer(x, m, 2, ffn_w_in[i, 1], ffn_w_out[i, 1], ln_g[i, 2], ln_b[i, 2])
    y_prompt = x

    rows = x_sample.shape[1] // GRID_W
    cos_a, sin_a = axial_rope(rows, A_HEAD_DIM)
    cos_b, sin_b = axial_rope(rows, B_QK_DIM)
    x = x_sample
    for i in range(DEPTH):
        j = i // N_MIXERS
        m = modulation(c, ada_w[i], ada_b[i])
        x = ffn_sublayer(x, m, 0, ffn_w_in[i, 0], ffn_w_out[i, 0], ln_g[i, 0], ln_b[i, 0])
        h, gate = modulate(x, m, 1)
        if i % N_MIXERS == 0:
            q, k, v = mixer_a_qkv(h, a_w_qkv[j], a_q_norm[j], a_k_norm[j])
            q = apply_rope(q, cos_a, sin_a)
            k = apply_rope(k, cos_a, sin_a)
            k_all = jnp.concatenate([cache_a_k[:, j], k], axis=1)
            v_all = jnp.concatenate([cache_a_v[:, j], v], axis=1)
            y = gqa_attention(q, k_all, v_all) @ a_w_o[j]
        else:
            lam_init = diff_lambda_init(i)
            q, k, v = mixer_b_qkv(h, b_w_qkv[j])
            q = apply_rope(q, cos_b, sin_b)
            k = apply_rope(k, cos_b, sin_b)
            k_all = jnp.concatenate([cache_b_k[:, j], k], axis=1)
            v_all = jnp.concatenate([cache_b_v[:, j], v], axis=1)
            o = diff_attention(q, k_all, v_all, diff_lambda(b_lambda[j], lam_init))
            y = diff_output(o, b_subln[j], lam_init, b_w_o[j])
        x = post_norm(x, gate * y, ln_g[i, 1], ln_b[i, 1])
        x = ffn_sublayer(x, m, 2, ffn_w_in[i, 1], ffn_w_out[i, 1], ln_g[i, 2], ln_b[i, 2])
    y_sample = x

    new_a_k = jnp.stack(new_a_k, axis=1)
    new_a_v = jnp.stack(new_a_v, axis=1)
    new_b_k = jnp.stack(new_b_k, axis=1)
    new_b_v = jnp.stack(new_b_v, axis=1)
    return (y_prompt, y_sample, new_a_k, new_a_v, new_b_k, new_b_v)
```

```cpp
#include <hip/hip_runtime.h>
#include <hip/hip_bf16.h>
#include <hip/hip_cooperative_groups.h>
#include <cstdio>
#include <cstdint>
__device__ __forceinline__ int fresh_tid() { int t = threadIdx.x; asm volatile("" : "+v"(t)); return t; }
namespace pg8 {
#define PG8_LAS __attribute__((address_space(3)))
typedef unsigned short bf16_t;
typedef short bf16x8 __attribute__((ext_vector_type(8)));
typedef float f32x4 __attribute__((ext_vector_type(4)));
typedef unsigned u32x4 __attribute__((ext_vector_type(4)));
constexpr int BM = 256, BK = 64, HALF = 128, HTB = HALF * BK * 2  , STAGE_BYTES = 8 * HTB, NXCD = 8, WGM = 8;

__host__ __device__ __forceinline__ int lds_byte(int r, int c) { const int st = (r >> 4) * 2 + (c >> 5), rr = r & 15, cc = c & 31, ob = rr * 64 + cc * 2; return st * 1024 + (ob ^ (((ob >> 9) & 1) << 5)); }
__host__ __device__ __forceinline__ void stage_rc(int b, int& R, int& C) { const int st = b / 1024, sb = b % 1024, swz = sb ^ (((sb >> 9) & 1) << 5); R = (st >> 1) * 16 + swz / 64; C = (st & 1) * 32 + (swz % 64) / 2; }
__host__ __device__ __forceinline__ int perm32(int rho) { const int n = rho >> 4, i = rho & 15; return 8 * (i >> 2) + 4 * n + (i & 3); }

struct Unit { int pm, pn; };
struct Gemm { const bf16_t* A; const bf16_t* Bt; int M, N, K; };

struct StaticOrder {
    int nM, nN, nwg, G, c;
    __host__ __device__ void init(int M, int N, int G_, int c_) { nM = M / BM; nN = N / BM; nwg = nM * nN; G = G_; c = c_; }
    __host__ __device__ bool next(int i, Unit& u) const {
        const long L = (long)i * G + c; if (L >= nwg) return false;
        int wgid = (int)L; { const int q = nwg / NXCD, r = nwg % NXCD, xcd = wgid % NXCD, off = wgid / NXCD; wgid = (xcd < r ? xcd * (q + 1) : r * (q + 1) + (xcd - r) * q) + off; }
        const int nig = WGM * nN, gid = wgid / nig, fm = gid * WGM, gsz = (nM - fm) < WGM ? (nM - fm) : WGM;
        u.pm = fm + ((wgid % nig) % gsz); u.pn = (wgid % nig) / gsz; return true;
    }
    __device__ __forceinline__ void a_ready(const Unit&) const {}
    __device__ __forceinline__ void done(const Unit&) const {}
};

__device__ __forceinline__ unsigned cvt_pk_bf16(float lo, float hi) { unsigned r; asm volatile("v_cvt_pk_bf16_f32 %0, %1, %2" : "=v"(r) : "v"(lo), "v"(hi)); return r; }
typedef float f32x2 __attribute__((ext_vector_type(2)));
__device__ __forceinline__ float silu_f(float g) { return g * __builtin_amdgcn_rcpf(1.0f + __builtin_amdgcn_exp2f(-1.4426950408889634f * g)); }
struct EpiSwiglu {
    static constexpr bool PERM = true, AFTER_DRAIN = false;
    bf16_t* O; int ldc;
    __device__ __forceinline__ void operator()(const f32x4 (&acc)[2][2][4][2], const Unit& u, int wr, int wc, int fr, int fq) const {
        const int row0 = u.pm * BM + wr * 64 + fr, col0 = u.pn * HALF + wc * 32 + 8 * fq;
#pragma unroll
        for (int ai = 0; ai < 2; ++ai)
#pragma unroll
            for (int m = 0; m < 4; ++m) {
                bf16_t* rowp = O + (size_t)(row0 + ai * HALF + m * 16) * ldc + col0;
                const f32x4 g0 = acc[ai][0][m][0], g1 = acc[ai][0][m][1], u0 = acc[ai][1][m][0], u1 = acc[ai][1][m][1];
                u32x4 w;
                w.x = cvt_pk_bf16(silu_f(g0[0]) * u0[0], silu_f(g0[1]) * u0[1]); w.y = cvt_pk_bf16(silu_f(g0[2]) * u0[2], silu_f(g0[3]) * u0[3]);
                w.z = cvt_pk_bf16(silu_f(g1[0]) * u1[0], silu_f(g1[1]) * u1[1]); w.w = cvt_pk_bf16(silu_f(g1[2]) * u1[2], silu_f(g1[3]) * u1[3]);
                *(u32x4*)rowp = w;
            }
    }
};
struct EpiPlain {
    static constexpr bool PERM = true, AFTER_DRAIN = false;
    bf16_t* O; int ldc;
    __device__ __forceinline__ void operator()(const f32x4 (&acc)[2][2][4][2], const Unit& u, int wr, int wc, int fr, int fq) const {
        const int row0 = u.pm * BM + wr * 64 + fr, col0 = u.pn * BM + wc * 32 + 8 * fq;
#pragma unroll
        for (int ai = 0; ai < 2; ++ai)
#pragma unroll
            for (int m = 0; m < 4; ++m) {
                bf16_t* rowp = O + (size_t)(row0 + ai * HALF + m * 16) * ldc + col0;
#pragma unroll
                for (int bj = 0; bj < 2; ++bj) {
                    const f32x4 v0 = acc[ai][bj][m][0], v1 = acc[ai][bj][m][1];
                    u32x4 w; w.x = cvt_pk_bf16(v0[0], v0[1]); w.y = cvt_pk_bf16(v0[2], v0[3]); w.z = cvt_pk_bf16(v1[0], v1[1]); w.w = cvt_pk_bf16(v1[2], v1[3]);
                    *(u32x4*)(rowp + bj * HALF) = w;
                }
            }
    }
};
struct EpiRes {
    static constexpr bool PERM = false, AFTER_DRAIN = false;
    float* X; const float* gate;   int gate_stride; float alpha, gs;
    __device__ __forceinline__ void operator()(const f32x4 (&acc)[2][2][4][2], const Unit& u, int wr, int wc, int fr, int fq) const {
        const int cidx = u.pm < 16 ? 0 : (u.pm < 24 ? 1 : 2);
        const int row0 = u.pm * BM + wr * 64 + fr, col0 = u.pn * BM + wc * 32 + 4 * fq;
        const float* gp = gate + (size_t)cidx * gate_stride + col0;
        f32x4 gv[2][2];
#pragma unroll
        for (int bj = 0; bj < 2; ++bj)
#pragma unroll
            for (int n = 0; n < 2; ++n) gv[bj][n] = *(const f32x4*)(gp + bj * HALF + n * 16) * gs;
#pragma unroll
        for (int ai = 0; ai < 2; ++ai)
#pragma unroll
            for (int m = 0; m < 4; ++m) {
                float* rowp = X + (size_t)(row0 + ai * HALF + m * 16) * 2048 + col0;
#pragma unroll
                for (int bj = 0; bj < 2; ++bj)
#pragma unroll
                    for (int n = 0; n < 2; ++n) {
                        const f32x4 x = *(const f32x4*)(rowp + bj * HALF + n * 16);
                        *(f32x4*)(rowp + bj * HALF + n * 16) = x * alpha + gv[bj][n] * acc[ai][bj][m][n];
                    }
                if (m & 1) asm volatile("" ::: "memory");
            }
    }
};
template <class Epi, class Sched, bool ALIGN_EPI = false, bool SP2 = false>
__device__ __forceinline__ void gemm_phase(PG8_LAS unsigned char* lds, const Gemm g, const Sched& S, const Epi& E) {
    const int tid = fresh_tid(), wid = __builtin_amdgcn_readfirstlane(tid >> 6), lane = tid & 63, wr = wid >> 2, wc = wid & 3, fr = lane & 15, fq = lane >> 4;
    const int K = g.K, nt = K / BK;
    unsigned voffA[2], voffB[2];
#pragma unroll
    for (int i = 0; i < 2; ++i) { int R, C; stage_rc(tid * 16 + i * 8192, R, C); const int Rb = Epi::PERM ? ((R & ~31) + perm32(R & 31)) : R;
        voffA[i] = (unsigned)(R * K + C) * 2u; voffB[i] = (unsigned)(Rb * K + C) * 2u; }
    const size_t kstep = (size_t)(BK * 2);
    const size_t hstep = (size_t)HALF * K * 2;
    const size_t tstep = 2 * hstep;
    const unsigned ldsw = (unsigned)wid * 1024u;
    const int aoff = lds_byte(wr * 64 + fr, fq * 8), boff = lds_byte(wc * 32 + fr, fq * 8);
#define PG8_SA(b, h) (((b) * 2 + (h)) * HTB)
#define PG8_SB(b, h) ((4 + (b) * 2 + (h)) * HTB)
#define PG8_STAGE(bufoff, gbase, voff) do { _Pragma("unroll") for (int _i = 0; _i < 2; ++_i) \
        __builtin_amdgcn_global_load_lds((const unsigned*)((const char*)(gbase) + (voff)[_i]), (PG8_LAS unsigned*)(lds + (bufoff) + ldsw + _i * 8192), 16, 0, 0); } while (0)
#define PG8_LDA(dst, b, h) do { _Pragma("unroll") for (int m = 0; m < 4; ++m) _Pragma("unroll") for (int k = 0; k < 2; ++k) dst[m][k] = *(const PG8_LAS bf16x8*)(lds + PG8_SA(b, h) + aoff + m * 2048 + k * 1024); } while (0)
#define PG8_LDB(dst, b, h) do { _Pragma("unroll") for (int n = 0; n < 2; ++n) _Pragma("unroll") for (int k = 0; k < 2; ++k) dst[n][k] = *(const PG8_LAS bf16x8*)(lds + PG8_SB(b, h) + boff + n * 2048 + k * 1024); } while (0)
#define PG8_MMA(ai, bj, At, Bt) do { __builtin_amdgcn_s_setprio(1); _Pragma("unroll") for (int m = 0; m < 4; ++m) _Pragma("unroll") for (int n = 0; n < 2; ++n) _Pragma("unroll") for (int k = 0; k < 2; ++k) \
        acc[ai][bj][m][n] = __builtin_amdgcn_mfma_f32_16x16x32_bf16(Bt[n][k], At[m][k], acc[ai][bj][m][n], 0, 0, 0); __builtin_amdgcn_s_setprio(0); } while (0)
#define PG8_WAIT_V(n) asm volatile("s_waitcnt vmcnt(" #n ")" ::: "memory")
#define PG8_WAIT_L(n) asm volatile("s_waitcnt lgkmcnt(" #n ")" ::: "memory")
#define PG8_BAR __builtin_amdgcn_s_barrier()
#define PG8_SCHED __builtin_amdgcn_sched_barrier(0)
    Unit cur, nxt; int ui = 0;
    if (!S.next(0, cur)) return;
    f32x4 acc[2][2][4][2];
#pragma unroll
    for (int a = 0; a < 2; ++a)
#pragma unroll
        for (int b = 0; b < 2; ++b)
#pragma unroll
            for (int m = 0; m < 4; ++m)
#pragma unroll
                for (int n = 0; n < 2; ++n) acc[a][b][m][n] = (f32x4){0.f, 0.f, 0.f, 0.f};
    bf16x8 At[4][2], B0[2][2], B1[2][2];
    const char* cA = (const char*)g.A + (size_t)cur.pm * tstep; const char* cB = (const char*)g.Bt + (size_t)cur.pn * tstep;
    S.a_ready(cur);
    if constexpr (SP2) {
        PG8_STAGE(PG8_SB(0, 0), cB, voffB); PG8_STAGE(PG8_SB(0, 1), cB + hstep, voffB); PG8_STAGE(PG8_SA(0, 0), cA, voffA); PG8_STAGE(PG8_SA(0, 1), cA + hstep, voffA);
        if (wr == 1) PG8_BAR;
        PG8_WAIT_V(2); PG8_BAR;
        PG8_STAGE(PG8_SB(1, 0), cB + kstep, voffB); PG8_STAGE(PG8_SA(1, 0), cA + kstep, voffA); PG8_STAGE(PG8_SB(1, 1), cB + hstep + kstep, voffB);
        PG8_WAIT_V(6); PG8_BAR;
    } else {
        PG8_STAGE(PG8_SB(0, 0), cB, voffB); PG8_STAGE(PG8_SA(0, 0), cA, voffA); PG8_STAGE(PG8_SB(0, 1), cB + hstep, voffB); PG8_STAGE(PG8_SA(0, 1), cA + hstep, voffA);
        if (wr == 1) PG8_BAR;
        PG8_WAIT_V(4); PG8_BAR;
        PG8_STAGE(PG8_SB(1, 0), cB + kstep, voffB); PG8_STAGE(PG8_SA(1, 0), cA + kstep, voffA); PG8_STAGE(PG8_SB(1, 1), cB + hstep + kstep, voffB);
        PG8_WAIT_V(6); PG8_BAR;
    }
    for (;;) {
        const bool has_next = S.next(ui + 1, nxt);
        const char* nA = has_next ? (const char*)g.A + (size_t)nxt.pm * tstep : cA; const char* nB = has_next ? (const char*)g.Bt + (size_t)nxt.pn * tstep : cB;
        for (int t = 0; t < nt; t += 2) {
            const bool last = (t == nt - 2);
            const char* a1 = cA + (size_t)(t + 1) * kstep;
            const char* a2 = last ? nA : cA + (size_t)(t + 2) * kstep; const char* b2 = last ? nB : cB + (size_t)(t + 2) * kstep;
            const char* a3 = a2 + kstep; const char* b3 = b2 + kstep;
            if (last && has_next) S.a_ready(nxt);
            if constexpr (SP2) {
            PG8_LDB(B0, 0, 0); PG8_LDB(B1, 0, 1); PG8_SCHED; PG8_LDA(At, 0, 0); PG8_STAGE(PG8_SA(1, 1), a1 + hstep, voffA);
            PG8_WAIT_V(8); PG8_WAIT_L(0); PG8_BAR; PG8_MMA(0, 0, At, B0); PG8_MMA(0, 1, At, B1); PG8_BAR; PG8_SCHED;
            PG8_LDA(At, 0, 1); PG8_STAGE(PG8_SB(0, 0), b2, voffB); PG8_STAGE(PG8_SB(0, 1), b2 + hstep, voffB); PG8_STAGE(PG8_SA(0, 0), a2, voffA);
            PG8_WAIT_V(8); PG8_WAIT_L(0); PG8_BAR; PG8_MMA(1, 0, At, B0); PG8_MMA(1, 1, At, B1); PG8_BAR; PG8_SCHED;
            PG8_LDB(B0, 1, 0); PG8_LDB(B1, 1, 1); PG8_SCHED; PG8_LDA(At, 1, 0); PG8_STAGE(PG8_SA(0, 1), a2 + hstep, voffA);
            PG8_WAIT_V(8); PG8_WAIT_L(0); PG8_BAR; PG8_MMA(0, 0, At, B0); PG8_MMA(0, 1, At, B1); PG8_BAR; PG8_SCHED;
            PG8_LDA(At, 1, 1); PG8_STAGE(PG8_SB(1, 0), b3, voffB); PG8_STAGE(PG8_SB(1, 1), b3 + hstep, voffB); PG8_STAGE(PG8_SA(1, 0), a3, voffA);
            PG8_WAIT_V(8); PG8_WAIT_L(0); PG8_BAR; PG8_MMA(1, 0, At, B0); PG8_MMA(1, 1, At, B1); PG8_BAR; PG8_SCHED;
            } else {
            PG8_LDB(B0, 0, 0); PG8_SCHED; PG8_LDA(At, 0, 0); PG8_STAGE(PG8_SA(1, 1), a1 + hstep, voffA);
            PG8_WAIT_L(8); PG8_BAR; PG8_WAIT_L(0); PG8_MMA(0, 0, At, B0); PG8_BAR; PG8_SCHED;
            PG8_LDB(B1, 0, 1); PG8_STAGE(PG8_SB(0, 0), b2, voffB);
            PG8_BAR; PG8_WAIT_L(0); PG8_MMA(0, 1, At, B1); PG8_BAR;
            PG8_LDA(At, 0, 1); PG8_STAGE(PG8_SA(0, 0), a2, voffA);
            PG8_BAR; PG8_WAIT_L(0); PG8_MMA(1, 0, At, B0); PG8_BAR; PG8_SCHED;
            PG8_STAGE(PG8_SB(0, 1), b2 + hstep, voffB);
            PG8_WAIT_V(6); PG8_BAR; PG8_MMA(1, 1, At, B1); PG8_BAR;
            PG8_LDB(B0, 1, 0); PG8_SCHED; PG8_LDA(At, 1, 0); PG8_STAGE(PG8_SA(0, 1), a2 + hstep, voffA);
            PG8_WAIT_L(8); PG8_BAR; PG8_WAIT_L(0); PG8_MMA(0, 0, At, B0); PG8_BAR; PG8_SCHED;
            PG8_LDB(B1, 1, 1); PG8_STAGE(PG8_SB(1, 0), b3, voffB);
            PG8_BAR; PG8_WAIT_L(0); PG8_MMA(0, 1, At, B1); PG8_BAR;
            PG8_LDA(At, 1, 1); PG8_STAGE(PG8_SA(1, 0), a3, voffA);
            PG8_BAR; PG8_WAIT_L(0); PG8_MMA(1, 0, At, B0); PG8_BAR; PG8_SCHED;
            PG8_STAGE(PG8_SB(1, 1), b3 + hstep, voffB);
            PG8_WAIT_V(6); PG8_BAR; PG8_MMA(1, 1, At, B1); PG8_BAR;
            }
        }
        if constexpr (ALIGN_EPI) { if (wr == 0) PG8_BAR; }
        if constexpr (!Epi::AFTER_DRAIN) { E(acc, cur, wr, wc, fr, fq); S.done(cur); }
        if (!has_next) break;
#pragma unroll
        for (int a = 0; a < 2; ++a)
#pragma unroll
            for (int b = 0; b < 2; ++b)
#pragma unroll
                for (int m = 0; m < 4; ++m)
#pragma unroll
                    for (int n = 0; n < 2; ++n) acc[a][b][m][n] = (f32x4){0.f, 0.f, 0.f, 0.f};
        cur = nxt; cA = nA; cB = nB; ++ui;
        if constexpr (ALIGN_EPI) { if (wr == 1) PG8_BAR; }
    }
    PG8_WAIT_V(0);
    if constexpr (!ALIGN_EPI) { if (wr == 0) PG8_BAR; }
    PG8_BAR;
    if constexpr (Epi::AFTER_DRAIN) { E.fused(acc, cur, wr, wc, fr, fq, lds, wid, lane); S.done(cur); }
#undef PG8_SA
#undef PG8_SB
#undef PG8_STAGE
#undef PG8_LDA
#undef PG8_LDB
#undef PG8_MMA
#undef PG8_WAIT_V
#undef PG8_WAIT_L
#undef PG8_BAR
#undef PG8_SCHED
}
}
namespace att {
using bf16 = __hip_bfloat16;
constexpr int DV = 128, NW = 8, QBLK = 32, KVBLK = 64;
constexpr float THR = 8.f;
constexpr size_t SHM_V = KVBLK * DV * 2, SHM_K = KVBLK * 128 * 2, SHM_ATTN = 2 * SHM_V + 2 * SHM_K + NW * 64 * 4;
using bf16x8 = __attribute__((ext_vector_type(8))) short;
using s16x4  = __attribute__((ext_vector_type(4))) short;
using f32x16 = __attribute__((ext_vector_type(16))) float;
using u32x4  = __attribute__((ext_vector_type(4))) unsigned;
#define KSWZ(row, colB) ((row) * 256 + ((colB) ^ (((row) & 7) << 4)))
#define KSWZ64(row, colB) ((row) * 128 + ((colB) ^ (((row) & 7) << 4)))
#define SBAR() __builtin_amdgcn_sched_barrier(0)
template <int DQK> __device__ __forceinline__ constexpr float scale_of() { return DQK == 128 ? 0.088388347648318440f : 0.125f; }
__device__ __forceinline__ int crow(int r, int hi) { return (r & 3) + 8 * (r >> 2) + 4 * hi; }
__device__ __forceinline__ unsigned cvtpk(float lo, float hi) { unsigned r; asm volatile("v_cvt_pk_bf16_f32 %0, %1, %2" : "=v"(r) : "v"(lo), "v"(hi)); return r; }

template <int DQK>
__device__ __forceinline__ void partialSM(f32x16& p0, f32x16& p1, float& m_reg, float& mn, float& alpha) {
  constexpr float SCALE = scale_of<DQK>();
  constexpr float C = SCALE * 1.4426950408889634f;
  float pmax = p0[0];
#pragma unroll
  for (int r = 1; r < 16; ++r) pmax = fmaxf(pmax, p0[r]);
#pragma unroll
  for (int r = 0; r < 16; ++r) pmax = fmaxf(pmax, p1[r]);
  { auto rr = __builtin_amdgcn_permlane32_swap(__float_as_uint(pmax), __float_as_uint(pmax), false, false);
    pmax = fmaxf(__uint_as_float(rr[0]), __uint_as_float(rr[1])); }
  if (__builtin_expect(__all(pmax - m_reg <= THR / SCALE), 1)) { mn = m_reg; alpha = 1.f; }
  else { mn = fmaxf(m_reg, pmax); alpha = __builtin_amdgcn_exp2f((m_reg - mn) * C); m_reg = mn; }
  float mnC = -mn * C;
#pragma unroll
  for (int r = 0; r < 16; ++r) p0[r] = fmaf(p0[r], C, mnC);
#pragma unroll
  for (int r = 0; r < 16; ++r) p1[r] = fmaf(p1[r], C, mnC);
#pragma unroll
  for (int r = 0; r < 16; ++r) p0[r] = __builtin_amdgcn_exp2f(p0[r]);
}
__device__ __forceinline__ void finishSM(f32x16& p0, f32x16& p1, float alpha, float& l_reg, bf16x8& pa0, bf16x8& pa1, bf16x8& pa2, bf16x8& pa3) {
#pragma unroll
  for (int r = 0; r < 16; ++r) p1[r] = __builtin_amdgcn_exp2f(p1[r]);
  float ps = 0;
#pragma unroll
  for (int r = 0; r < 16; ++r) ps += p0[r];
#pragma unroll
  for (int r = 0; r < 16; ++r) ps += p1[r];
  { auto rr = __builtin_amdgcn_permlane32_swap(__float_as_uint(ps), __float_as_uint(ps), false, false);
    ps = __uint_as_float(rr[0]) + __uint_as_float(rr[1]); }
  l_reg = l_reg * alpha + ps;
#define PK4(P, BASE, OUT) do { unsigned a0 = cvtpk(P[BASE + 0], P[BASE + 1]), a1 = cvtpk(P[BASE + 2], P[BASE + 3]);   \
    unsigned b0 = cvtpk(P[BASE + 4], P[BASE + 5]), b1 = cvtpk(P[BASE + 6], P[BASE + 7]);                              \
    auto r0 = __builtin_amdgcn_permlane32_swap(a0, b0, false, false); auto r1 = __builtin_amdgcn_permlane32_swap(a1, b1, false, false); \
    u32x4 w = {r0[0], r1[0], r0[1], r1[1]}; OUT = *reinterpret_cast<bf16x8*>(&w); } while (0)
  PK4(p0, 0, pa0); PK4(p0, 8, pa1); PK4(p1, 0, pa2); PK4(p1, 8, pa3);
#undef PK4
}
template <int DQK>
__device__ __forceinline__ void qkt(f32x16& p0, f32x16& p1, const bf16* Ks, const bf16x8* qr, int r32, int hi) {
  p0 = f32x16{}; p1 = f32x16{};
#pragma unroll
  for (int d0 = 0; d0 < DQK / 16; ++d0) { int cb = (d0 * 16 + hi * 8) * 2;
    bf16x8 b0, b1;
    if constexpr (DQK == 128) { b0 = *reinterpret_cast<const bf16x8*>((const char*)Ks + KSWZ(r32, cb)); b1 = *reinterpret_cast<const bf16x8*>((const char*)Ks + KSWZ(32 + r32, cb)); }
    else { b0 = *reinterpret_cast<const bf16x8*>((const char*)Ks + KSWZ64(r32, cb)); b1 = *reinterpret_cast<const bf16x8*>((const char*)Ks + KSWZ64(32 + r32, cb)); }
    p0 = __builtin_amdgcn_mfma_f32_32x32x16_bf16(b0, qr[d0], p0, 0, 0, 0);
    p1 = __builtin_amdgcn_mfma_f32_32x32x16_bf16(b1, qr[d0], p1, 0, 0, 0); }
}
__device__ __forceinline__ int v_st(int k, int c) { const int kk = (k & ~0xC) | ((k & 4) << 1) | ((k & 8) >> 1); return ((kk >> 3) * 4 + (c >> 5)) * 512 + ((kk & 7) * 32 + (c & 31)) * 2; }
__device__ __forceinline__ int v_rd_base(int lane) { return ((lane & 3) << 3) | (((lane >> 2) & 3) << 6) | (((lane >> 4) & 1) << 5) | (((lane >> 5) & 1) << 8); }
constexpr int v_rd_off(int d0, int ks, int half) { return d0 * 512 + ks * 4096 + half * 2048; }
template <int OFF> __device__ __forceinline__ s16x4 tr_read(int vb) {
  s16x4 r; asm volatile("ds_read_b64_tr_b16 %0, %1 offset:%2" : "=&v"(r) : "v"(vb), "i"(OFF) : "memory"); return r;
}
template <int D0> __device__ __forceinline__ void pv_one(f32x16& od, int vb, bf16x8 pa0, bf16x8 pa1, bf16x8 pa2, bf16x8 pa3) {
  const s16x4 l0 = tr_read<v_rd_off(D0, 0, 0)>(vb), h0 = tr_read<v_rd_off(D0, 0, 1)>(vb), l1 = tr_read<v_rd_off(D0, 1, 0)>(vb), h1 = tr_read<v_rd_off(D0, 1, 1)>(vb);
  const s16x4 l2 = tr_read<v_rd_off(D0, 2, 0)>(vb), h2 = tr_read<v_rd_off(D0, 2, 1)>(vb), l3 = tr_read<v_rd_off(D0, 3, 0)>(vb), h3 = tr_read<v_rd_off(D0, 3, 1)>(vb);
  asm volatile("s_waitcnt lgkmcnt(0)" ::: "memory"); SBAR();
#define PK(L, H) (bf16x8){L[0], L[1], L[2], L[3], H[0], H[1], H[2], H[3]}
  od = __builtin_amdgcn_mfma_f32_32x32x16_bf16(pa0, PK(l0, h0), od, 0, 0, 0);
  od = __builtin_amdgcn_mfma_f32_32x32x16_bf16(pa1, PK(l1, h1), od, 0, 0, 0);
  od = __builtin_amdgcn_mfma_f32_32x32x16_bf16(pa2, PK(l2, h2), od, 0, 0, 0);
  od = __builtin_amdgcn_mfma_f32_32x32x16_bf16(pa3, PK(l3, h3), od, 0, 0, 0);
#undef PK
}
__device__ __forceinline__ void pv_d0(f32x16* o, int vb, bf16x8 pa0, bf16x8 pa1, bf16x8 pa2, bf16x8 pa3) {
  pv_one<0>(o[0], vb, pa0, pa1, pa2, pa3); pv_one<1>(o[1], vb, pa0, pa1, pa2, pa3); pv_one<2>(o[2], vb, pa0, pa1, pa2, pa3); pv_one<3>(o[3], vb, pa0, pa1, pa2, pa3);
}
__device__ __forceinline__ void store_o(float* p, float v) { *p = v; }
__device__ __forceinline__ void store_o(bf16* p, float v) { *p = __float2bfloat16(v); }

template <int DQK, typename TO>
__device__ __forceinline__ void attn_dense_body(const bf16* __restrict__ Qb, int ldq, const bf16* __restrict__ Kh, int ldk, const bf16* __restrict__ Vh, int ldv,
                                                TO* __restrict__ Ob, int ldo, int seq, char* lds) {
  const int tid = fresh_tid(), wid = tid >> 6, lane = tid & 63, r32 = lane & 31, hi = lane >> 5;
  bf16* V_lds = (bf16*)lds; bf16* K_lds = (bf16*)(lds + 2 * SHM_V);
  float* ws = (float*)(lds + 2 * SHM_V + 2 * SHM_K) + wid * 64; float* li_l = ws; float* al_l = ws + 32;
  float m_reg = -1e30f, l_reg = 0; f32x16 o[4] = {}; bf16x8 qr[DQK / 16];
  const bf16* Qw = Qb + (long)(wid * QBLK + r32) * ldq + hi * 8;
#pragma unroll
  for (int d0 = 0; d0 < DQK / 16; ++d0) qr[d0] = *reinterpret_cast<const bf16x8*>(Qw + d0 * 16);
  const int sr = tid >> 4, sc = (tid & 15) * 8, vst0 = v_st(sr, sc), vst1 = v_st(32 + sr, sc);
  const int kr = (DQK == 128) ? sr : (tid >> 3), kc = (DQK == 128) ? sc : (tid & 7) * 8;
  const int vb0 = (int)(uintptr_t)V_lds + v_rd_base(lane);
  struct { bf16x8 vs0, vs1, ks0, ks1; } sr_[2];
#define SLOAD(i, k0) do { sr_[i].vs0 = *reinterpret_cast<const bf16x8*>(&Vh[(long)((k0) + sr) * ldv + sc]); sr_[i].vs1 = *reinterpret_cast<const bf16x8*>(&Vh[(long)((k0) + 32 + sr) * ldv + sc]); \
    sr_[i].ks0 = *reinterpret_cast<const bf16x8*>(&Kh[(long)((k0) + kr) * ldk + kc]); \
    if constexpr (DQK == 128) sr_[i].ks1 = *reinterpret_cast<const bf16x8*>(&Kh[(long)((k0) + 32 + kr) * ldk + kc]); } while (0)
#define SWRITE(b, i) do { *(bf16x8*)((char*)V_lds + (b) * SHM_V + vst0) = sr_[i].vs0;          \
    *(bf16x8*)((char*)V_lds + (b) * SHM_V + vst1) = sr_[i].vs1; int kcb = kc * 2;               \
    if constexpr (DQK == 128) { *(bf16x8*)((char*)K_lds + (b) * SHM_K + KSWZ(kr, kcb)) = sr_[i].ks0;                       \
      *(bf16x8*)((char*)K_lds + (b) * SHM_K + KSWZ(32 + kr, kcb)) = sr_[i].ks1; }               \
    else { *(bf16x8*)((char*)K_lds + (b) * SHM_K + KSWZ64(kr, kcb)) = sr_[i].ks0; } } while (0)
#define SWAIT() do { if constexpr (DQK == 128) asm volatile("s_waitcnt vmcnt(4)" ::: "memory"); else asm volatile("s_waitcnt vmcnt(3)" ::: "memory"); } while (0)
#define RESC(a) do { if (__any((a) < 1.f)) { if (hi == 0) al_l[r32] = (a); asm volatile("s_waitcnt lgkmcnt(0)" ::: "memory"); \
    _Pragma("unroll") for (int d = 0; d < 4; ++d) _Pragma("unroll") for (int r = 0; r < 16; ++r) o[d][r] *= al_l[crow(r, hi)]; } } while (0)
  f32x16 pA0, pA1, pB0, pB1; float mnA, mnB, alA, alB; bf16x8 pa0, pa1, pa2, pa3; const int NT = seq / KVBLK;
  constexpr int SE = 0, SO = 1;
  SLOAD(SE, 0); asm volatile("s_waitcnt vmcnt(0)" ::: "memory"); SWRITE(0, SE); __syncthreads();
  qkt<DQK>(pA0, pA1, K_lds, qr, r32, hi); partialSM<DQK>(pA0, pA1, m_reg, mnA, alA);
  SLOAD(SO, KVBLK); if (2 < NT) SLOAD(SE, 2 * KVBLK);
  if (2 < NT) { SWAIT(); } else { asm volatile("s_waitcnt vmcnt(0)" ::: "memory"); }
  SWRITE(1, SO); __syncthreads();
  for (int j = 1; j + 1 < NT; j += 2) {
    SBAR(); qkt<DQK>(pB0, pB1, (bf16*)((char*)K_lds + SHM_K), qr, r32, hi);
    finishSM(pA0, pA1, alA, l_reg, pa0, pa1, pa2, pa3); SBAR();
    SLOAD(SO, (j + 2) * KVBLK); SBAR();
    pv_d0(o, vb0, pa0, pa1, pa2, pa3); partialSM<DQK>(pB0, pB1, m_reg, mnB, alB);
    __syncthreads(); SWAIT(); SWRITE(0, SE);
    RESC(alB); __syncthreads();
    SBAR(); qkt<DQK>(pA0, pA1, K_lds, qr, r32, hi);
    finishSM(pB0, pB1, alB, l_reg, pa0, pa1, pa2, pa3); SBAR();
    if (j + 3 < NT) SLOAD(SE, (j + 3) * KVBLK); SBAR();
    pv_d0(o, vb0 + (int)SHM_V, pa0, pa1, pa2, pa3); partialSM<DQK>(pA0, pA1, m_reg, mnA, alA);
    __syncthreads(); if (j + 3 < NT) { SWAIT(); } else { asm volatile("s_waitcnt vmcnt(0)" ::: "memory"); } SWRITE(1, SO);
    RESC(alA); __syncthreads();
  }
  SBAR(); qkt<DQK>(pB0, pB1, (bf16*)((char*)K_lds + SHM_K), qr, r32, hi);
  finishSM(pA0, pA1, alA, l_reg, pa0, pa1, pa2, pa3); SBAR();
  pv_d0(o, vb0, pa0, pa1, pa2, pa3); partialSM<DQK>(pB0, pB1, m_reg, mnB, alB);
  __syncthreads(); RESC(alB);
  finishSM(pB0, pB1, alB, l_reg, pa0, pa1, pa2, pa3); SBAR();
  pv_d0(o, vb0 + (int)SHM_V, pa0, pa1, pa2, pa3);
  if (hi == 0) li_l[r32] = l_reg; asm volatile("s_waitcnt lgkmcnt(0)" ::: "memory");
  float rli[16];
#pragma unroll
  for (int r = 0; r < 16; ++r) rli[r] = __builtin_amdgcn_rcpf(li_l[crow(r, hi)]);
  TO* Ow = Ob + (long)(wid * QBLK) * ldo;
#pragma unroll
  for (int r = 0; r < 16; ++r) { int orow = crow(r, hi);
#pragma unroll
    for (int d0 = 0; d0 < 4; ++d0) store_o(&Ow[(long)orow * ldo + d0 * 32 + r32], o[d0][r] * rli[r]); }
  __syncthreads();
#undef SLOAD
#undef SWRITE
#undef SWAIT
#undef RESC
}
#undef KSWZ
#undef KSWZ64
#undef SBAR
}
namespace cg = cooperative_groups;
#define LAS __attribute__((address_space(3)))
typedef unsigned short bf16_t;
typedef float f32x4 __attribute__((ext_vector_type(4)));
typedef float f32x2 __attribute__((ext_vector_type(2)));
typedef unsigned u32x4 __attribute__((ext_vector_type(4)));
typedef unsigned u32x2 __attribute__((ext_vector_type(2)));

constexpr int NWAVES = 8, NTHREADS = 512;
constexpr int DM = 2048, DFF = 5504, MTOK = 8192, NCTX = 4096;
constexpr int NMOD = 9 * DM;
constexpr int NQKV_A = 3072, NQKV_B = 6144;
constexpr int KVROWS = 4096 + 2 * 2304;
constexpr float LN_EPS = 1e-6f;
constexpr float ALPHA = 1.4142135623730951f;
constexpr float LAM_INIT = 0.35550906759f;
constexpr int LDS_BYTES = 147456;

constexpr size_t al256(size_t x) { return (x + 255) / 256 * 256; }
constexpr size_t WS_MOD = 0;
constexpr size_t WS_WIN = al256(WS_MOD + (size_t)2 * 3 * NMOD * 4);
constexpr size_t SZ_WIN = (size_t)2 * DFF * DM * 2;
constexpr size_t WS_WOUT = WS_WIN + 4 * SZ_WIN;
constexpr size_t SZ_WOUT = (size_t)DM * DFF * 2;
constexpr size_t WS_WQA = WS_WOUT + 4 * SZ_WOUT;
constexpr size_t WS_WQB = WS_WQA + (size_t)NQKV_A * DM * 2;
constexpr size_t WS_WOA = WS_WQB + (size_t)NQKV_B * DM * 2;
constexpr size_t WS_WOB = WS_WOA + (size_t)DM * DM * 2;
constexpr size_t WS_H = WS_WOB + (size_t)DM * DM * 2;
constexpr size_t WS_ACT = WS_H + (size_t)MTOK * DM * 2;
constexpr size_t WS_QKV = WS_ACT + (size_t)MTOK * DFF * 2;
constexpr size_t WS_KA = WS_QKV + (size_t)MTOK * NQKV_B * 2;
constexpr size_t WS_VA = WS_KA + (size_t)KVROWS * 512 * 2;
constexpr size_t WS_KB = WS_VA + (size_t)KVROWS * 512 * 2;
constexpr size_t WS_VB = WS_KB + (size_t)KVROWS * 2048 * 2;
constexpr size_t WS_O = WS_VB + (size_t)KVROWS * 2048 * 2;
constexpr size_t WS_OT = WS_O + (size_t)MTOK * DM * 2;
constexpr size_t WS_END = WS_OT + (size_t)MTOK * 4096 * 4;

constexpr size_t OUT_X = 0, OUT_NAK = (size_t)MTOK * DM, OUT_NAV = OUT_NAK + (size_t)NCTX * 512, OUT_NBK = OUT_NAV + (size_t)NCTX * 512, OUT_NBV = OUT_NBK + (size_t)NCTX * 2048;

__device__ __forceinline__ float wave_sum(float v) {
#pragma unroll
    for (int o = 1; o < 64; o <<= 1) v += __shfl_xor(v, o);
    return v;
}
__device__ __forceinline__ unsigned pk_bf16(float lo, float hi) { return pg8::cvt_pk_bf16(lo, hi); }
__device__ __forceinline__ float bf2f(bf16_t b) { return __uint_as_float((unsigned)b << 16); }
__device__ __forceinline__ bf16_t f2bf(float f) { return (bf16_t)(pk_bf16(f, 0.f) & 0xffffu); }
#define LDS_WAIT() asm volatile("s_waitcnt lgkmcnt(0)" ::: "memory")

struct Args { const float* in[22]; float* out; unsigned char* ws; int ph_lo, ph_hi; };

__device__ __forceinline__ void p0_gemv(const Args& a, LAS unsigned char* lds, int G) {
    const int tid = fresh_tid(), lane = tid & 63, wave = tid >> 6;
    LAS float* sc = (LAS float*)lds;
    LAS float* red = sc + 3 * DM;
    const float* c = a.in[6]; const float* cctx = a.in[7];
    for (int i = tid; i < 3 * DM; i += NTHREADS) { const int ci = i / DM, k = i % DM; const float v = ci == 0 ? cctx[k] : c[(ci - 1) * DM + k]; sc[i] = pg8::silu_f(v); }
    __syncthreads();
    float* MOD = (float*)(a.ws + WS_MOD);
    for (int item = blockIdx.x; item < 2 * 144; item += G) {
        const int l = item / 144, cgp = item % 144;
        const float* W = a.in[8] + (size_t)l * DM * NMOD + cgp * 128 + 2 * lane;
        f32x2 acc0 = {0.f, 0.f}, acc1 = {0.f, 0.f}, acc2 = {0.f, 0.f};
        const int kb = wave * 256;
        for (int k = kb; k < kb + 256; k += 8) {
            f32x2 w[8];
#pragma unroll
            for (int i = 0; i < 8; ++i) w[i] = *(const f32x2*)(W + (size_t)(k + i) * NMOD);
#pragma unroll
            for (int i = 0; i < 8; ++i) { acc0 += w[i] * sc[k + i]; acc1 += w[i] * sc[DM + k + i]; acc2 += w[i] * sc[2 * DM + k + i]; }
        }
        *(LAS f32x2*)(red + (wave * 3 + 0) * 128 + 2 * lane) = acc0;
        *(LAS f32x2*)(red + (wave * 3 + 1) * 128 + 2 * lane) = acc1;
        *(LAS f32x2*)(red + (wave * 3 + 2) * 128 + 2 * lane) = acc2;
        __syncthreads();
        if (tid < 384) { const int ci = tid >> 7, j = tid & 127; float s = 0.f;
#pragma unroll
            for (int w = 0; w < 8; ++w) s += red[(w * 3 + ci) * 128 + j];
            MOD[(size_t)(l * 3 + ci) * NMOD + cgp * 128 + j] = s + a.in[9][(size_t)l * NMOD + cgp * 128 + j]; }
        __syncthreads();
    }
}
__device__ __forceinline__ void p0_transpose_tile(const float* W, int K, int N, bf16_t* WT, int k0, int n0, int rb, LAS float* scr, int lane) {
    const int kk0 = lane >> 4, c4 = (lane & 15) * 4;
    f32x4 v[16];
#pragma unroll
    for (int i = 0; i < 16; ++i) v[i] = *(const f32x4*)(W + (size_t)(k0 + 4 * i + kk0) * N + n0 + c4);
#pragma unroll
    for (int i = 0; i < 16; ++i) { LAS float* d = scr + (4 * i + kk0) * 65 + c4; d[0] = v[i].x; d[1] = v[i].y; d[2] = v[i].z; d[3] = v[i].w; }
    LDS_WAIT();
    const int c = lane & 7;
#pragma unroll
    for (int j = 0; j < 8; ++j) { const int n = (lane >> 3) + 8 * j; const LAS float* s = scr + (8 * c) * 65 + n;
        u32x4 o; o.x = pk_bf16(s[0 * 65], s[1 * 65]); o.y = pk_bf16(s[2 * 65], s[3 * 65]); o.z = pk_bf16(s[4 * 65], s[5 * 65]); o.w = pk_bf16(s[6 * 65], s[7 * 65]);
        *(u32x4*)(WT + (size_t)(rb + n) * K + k0 + 8 * c) = o; }
    LDS_WAIT();
}
__device__ __forceinline__ void p0_convert(const Args& a, LAS unsigned char* lds, int G) {
    const int tid = fresh_tid(), lane = tid & 63, wave = tid >> 6;
    LAS float* scr = (LAS float*)lds + wave * (64 * 65);
    const int gw = blockIdx.x * NWAVES + wave, NGW = G * NWAVES;
    constexpr int I_IN = 32 * 172, I_OUT = 86 * 32, I_QA = 32 * 48, I_QB = 32 * 96, I_O = 32 * 32;
    constexpr int NITEMS = 4 * I_IN + 4 * I_OUT + I_QA + I_QB + 2 * I_O;
    for (int it = gw; it < NITEMS; it += NGW) {
        int r = it;
        if (r < 4 * I_IN) { const int w = r / I_IN; r -= w * I_IN; const int kb = r / 172, nb = r % 172, n0 = nb * 64;
            const int f = n0 < DFF ? n0 : n0 - DFF; const int rb = 256 * (f >> 7) + (f & 127) + (n0 < DFF ? 0 : 128);
            p0_transpose_tile(a.in[12] + (size_t)w * DM * 2 * DFF, DM, 2 * DFF, (bf16_t*)(a.ws + WS_WIN + w * SZ_WIN), kb * 64, n0, rb, scr, lane); continue; }
        r -= 4 * I_IN;
        if (r < 4 * I_OUT) { const int w = r / I_OUT; r -= w * I_OUT; const int kb = r / 32, nb = r % 32;
            p0_transpose_tile(a.in[13] + (size_t)w * DFF * DM, DFF, DM, (bf16_t*)(a.ws + WS_WOUT + w * SZ_WOUT), kb * 64, nb * 64, nb * 64, scr, lane); continue; }
        r -= 4 * I_OUT;
        if (r < I_QA) { const int kb = r / 48, nb = r % 48; p0_transpose_tile(a.in[14], DM, NQKV_A, (bf16_t*)(a.ws + WS_WQA), kb * 64, nb * 64, nb * 64, scr, lane); continue; }
        r -= I_QA;
        if (r < I_QB) { const int kb = r / 96, nb = r % 96; p0_transpose_tile(a.in[18], DM, NQKV_B, (bf16_t*)(a.ws + WS_WQB), kb * 64, nb * 64, nb * 64, scr, lane); continue; }
        r -= I_QB;
        if (r < I_O) { const int kb = r / 32, nb = r % 32; p0_transpose_tile(a.in[17], DM, DM, (bf16_t*)(a.ws + WS_WOA), kb * 64, nb * 64, nb * 64, scr, lane); continue; }
        r -= I_O;
        { const int kb = r / 32, nb = r % 32; p0_transpose_tile(a.in[21], DM, DM, (bf16_t*)(a.ws + WS_WOB), kb * 64, nb * 64, nb * 64, scr, lane); }
    }
    const size_t gt = (size_t)blockIdx.x * NTHREADS + tid, NGT = (size_t)G * NTHREADS;
    constexpr size_t NA8 = (size_t)2 * 256 * 512 / 8, NB8 = (size_t)2 * 256 * 2048 / 8;
    for (size_t i = gt; i < 2 * NA8 + 2 * NB8; i += NGT) {
        const float* src; bf16_t* dst; size_t j; int wdt;
        if (i < NA8) { j = i; src = a.in[2]; dst = (bf16_t*)(a.ws + WS_KA); wdt = 512; }
        else if (i < 2 * NA8) { j = i - NA8; src = a.in[3]; dst = (bf16_t*)(a.ws + WS_VA); wdt = 512; }
        else if (i < 2 * NA8 + NB8) { j = i - 2 * NA8; src = a.in[4]; dst = (bf16_t*)(a.ws + WS_KB); wdt = 2048; }
        else { j = i - 2 * NA8 - NB8; src = a.in[5]; dst = (bf16_t*)(a.ws + WS_VB); wdt = 2048; }
        const size_t e = j * 8, row = e / wdt, col = e % wdt, b = row >> 8, t = row & 255;
        const f32x4 x0 = *(const f32x4*)(src + e), x1 = *(const f32x4*)(src + e + 4);
        u32x4 o; o.x = pk_bf16(x0.x, x0.y); o.y = pk_bf16(x0.z, x0.w); o.z = pk_bf16(x1.x, x1.y); o.w = pk_bf16(x1.z, x1.w);
        *(u32x4*)(dst + (size_t)(4096 + b * 2304 + t) * wdt + col) = o;
    }
}

__device__ __forceinline__ int cidx_of(int row) { return row < NCTX ? 0 : 1 + ((row - NCTX) >> 11); }
__device__ __forceinline__ void ln_phase(const Args& a, bool first, const float* g, const float* bta, const float* modp, int G) {
    const int tid = fresh_tid(), lane = tid & 63, wave = tid >> 6;
    const int gw = blockIdx.x * NWAVES + wave, NGW = G * NWAVES;
    float* X = a.out + OUT_X; bf16_t* H = (bf16_t*)(a.ws + WS_H);
    for (int row = gw; row < MTOK; row += NGW) {
        const float* src = first ? (row < NCTX ? a.in[0] + (size_t)row * DM : a.in[1] + (size_t)(row - NCTX) * DM) : X + (size_t)row * DM;
        f32x4 v[8];
#pragma unroll
        for (int j = 0; j < 8; ++j) v[j] = *(const f32x4*)(src + 4 * lane + 256 * j);
        if (!first) {
            float s = 0.f;
#pragma unroll
            for (int j = 0; j < 8; ++j) s += (v[j].x + v[j].y) + (v[j].z + v[j].w);
            const float mean = wave_sum(s) * (1.f / DM); float s2 = 0.f;
#pragma unroll
            for (int j = 0; j < 8; ++j) { v[j] = v[j] - mean; s2 += (v[j].x * v[j].x + v[j].y * v[j].y) + (v[j].z * v[j].z + v[j].w * v[j].w); }
            const float rstd = 1.0f / sqrtf(wave_sum(s2) * (1.f / DM) + LN_EPS);
#pragma unroll
            for (int j = 0; j < 8; ++j) { const f32x4 gg = *(const f32x4*)(g + 4 * lane + 256 * j), bb = *(const f32x4*)(bta + 4 * lane + 256 * j); v[j] = v[j] * rstd * gg + bb; }
        }
#pragma unroll
        for (int j = 0; j < 8; ++j) *(f32x4*)(X + (size_t)row * DM + 4 * lane + 256 * j) = v[j];
        if (modp) {
            const float* mp = modp + (size_t)cidx_of(row) * NMOD;
#pragma unroll
            for (int j = 0; j < 8; ++j) { const f32x4 sh = *(const f32x4*)(mp + 4 * lane + 256 * j), scl = *(const f32x4*)(mp + DM + 4 * lane + 256 * j);
                const f32x4 h = v[j] * (scl + 1.0f) + sh; u32x2 o; o.x = pk_bf16(h.x, h.y); o.y = pk_bf16(h.z, h.w);
                *(u32x2*)(H + (size_t)row * DM + 4 * lane + 256 * j) = o; }
        }
    }
}
__device__ __forceinline__ void normrope_a(const Args& a, int G) {
    const int tid = fresh_tid(), lane = tid & 63, wave = tid >> 6;
    const int gw = blockIdx.x * NWAVES + wave, NGW = G * NWAVES;
    bf16_t* QKV = (bf16_t*)(a.ws + WS_QKV); bf16_t* KA = (bf16_t*)(a.ws + WS_KA); bf16_t* VA = (bf16_t*)(a.ws + WS_VA);
    const float qn0 = a.in[15][lane], qn1 = a.in[15][64 + lane], kn0 = a.in[16][lane], kn1 = a.in[16][64 + lane];
    const float inv = __builtin_amdgcn_exp2f(-13.287712379549449f * (float)(lane & 31) * (1.0f / 32.0f));
    for (int row = gw; row < MTOK; row += NGW) {
        const bool lat = row >= NCTX; const int s = (row - NCTX) & 2047, b = (row - NCTX) >> 11;
        float cs = 1.f, sn = 0.f;
        if (lat) { const float pos = (float)(lane < 32 ? (s >> 6) : (s & 63)); const float ang = pos * inv; cs = __cosf(ang); sn = __sinf(ang); }
        const int kvrow = lat ? 4096 + b * 2304 + 256 + s : row;
        bf16_t* src = QKV + (size_t)row * NQKV_A;
#pragma unroll 4
        for (int j = 0; j < 20; ++j) {
            const float x1 = bf2f(src[j * 128 + lane]), x2 = bf2f(src[j * 128 + 64 + lane]);
            const float rstd = 1.0f / sqrtf(wave_sum(x1 * x1 + x2 * x2) * (1.f / 128.f) + LN_EPS);
            const float y1 = x1 * rstd * (j < 16 ? qn0 : kn0), y2 = x2 * rstd * (j < 16 ? qn1 : kn1);
            const float o1 = y1 * cs - y2 * sn, o2 = y2 * cs + y1 * sn;
            if (j < 16) { src[j * 128 + lane] = f2bf(o1); src[j * 128 + 64 + lane] = f2bf(o2); }
            else { bf16_t* kd = KA + (size_t)kvrow * 512 + (j - 16) * 128; kd[lane] = f2bf(o1); kd[64 + lane] = f2bf(o2);
                if (!lat) { float* od = a.out + OUT_NAK + (size_t)row * 512 + (j - 16) * 128; od[lane] = o1; od[64 + lane] = o2; } }
        }
        const u32x4 vv = *(const u32x4*)(src + 2560 + lane * 8);
        *(u32x4*)(VA + (size_t)kvrow * 512 + lane * 8) = vv;
        if (!lat) { float* od = a.out + OUT_NAV + (size_t)row * 512 + lane * 8;
            f32x4 lo = {__uint_as_float(vv.x << 16), __uint_as_float(vv.x & 0xffff0000u), __uint_as_float(vv.y << 16), __uint_as_float(vv.y & 0xffff0000u)};
            f32x4 hi = {__uint_as_float(vv.z << 16), __uint_as_float(vv.z & 0xffff0000u), __uint_as_float(vv.w << 16), __uint_as_float(vv.w & 0xffff0000u)};
            *(f32x4*)od = lo; *(f32x4*)(od + 4) = hi; }
    }
}
__device__ __forceinline__ void normrope_b(const Args& a, int G) {
    const int tid = fresh_tid(), lane = tid & 63, wave = tid >> 6;
    const int gw = blockIdx.x * NWAVES + wave, NGW = G * NWAVES;
    bf16_t* QKV = (bf16_t*)(a.ws + WS_QKV); bf16_t* KB = (bf16_t*)(a.ws + WS_KB); bf16_t* VB = (bf16_t*)(a.ws + WS_VB);
    const int i32 = lane & 31, vsel = lane >> 5;
    const float inv = __builtin_amdgcn_exp2f(-13.287712379549449f * (float)(i32 & 15) * (1.0f / 16.0f));
    for (int row = gw; row < MTOK; row += NGW) {
        const bool lat = row >= NCTX; const int s = (row - NCTX) & 2047, b = (row - NCTX) >> 11;
        const int kvrow = lat ? 4096 + b * 2304 + 256 + s : row;
        bf16_t* src = QKV + (size_t)row * NQKV_B;
        if (lat) {
            const float pos = (float)(i32 < 16 ? (s >> 6) : (s & 63)); const float ang = pos * inv; const float cs = __cosf(ang), sn = __sinf(ang);
#pragma unroll 4
            for (int it = 0; it < 32; ++it) {
                const int vec = 2 * it + vsel; bf16_t* p = src + vec * 64;
                const float x1 = bf2f(p[i32]), x2 = bf2f(p[32 + i32]);
                const float o1 = x1 * cs - x2 * sn, o2 = x2 * cs + x1 * sn;
                bf16_t* d = vec < 32 ? p : KB + (size_t)kvrow * 2048 + (vec - 32) * 64;
                d[i32] = f2bf(o1); d[32 + i32] = f2bf(o2);
            }
#pragma unroll
            for (int j = 0; j < 4; ++j) *(u32x4*)(VB + (size_t)kvrow * 2048 + j * 512 + lane * 8) = *(const u32x4*)(src + 4096 + j * 512 + lane * 8);
        } else {
#pragma unroll
            for (int j = 0; j < 8; ++j) {
                const u32x4 vv = *(const u32x4*)(src + 2048 + j * 512 + lane * 8);
                bf16_t* dst = (j < 4 ? KB : VB) + (size_t)kvrow * 2048 + (j & 3) * 512 + lane * 8;
                *(u32x4*)dst = vv;
                float* od = a.out + (j < 4 ? OUT_NBK : OUT_NBV) + (size_t)row * 2048 + (j & 3) * 512 + lane * 8;
                f32x4 lo = {__uint_as_float(vv.x << 16), __uint_as_float(vv.x & 0xffff0000u), __uint_as_float(vv.y << 16), __uint_as_float(vv.y & 0xffff0000u)};
                f32x4 hi = {__uint_as_float(vv.z << 16), __uint_as_float(vv.z & 0xffff0000u), __uint_as_float(vv.w << 16), __uint_as_float(vv.w & 0xffff0000u)};
                *(f32x4*)od = lo; *(f32x4*)(od + 4) = hi;
            }
        }
    }
}
__device__ __forceinline__ void combine_b(const Args& a, int G) {
    const int tid = fresh_tid(), lane = tid & 63, wave = tid >> 6;
    const int gw = blockIdx.x * NWAVES + wave, NGW = G * NWAVES;
    const float* lp = a.in[19];
    const float lam = __expf(wave_sum(lp[lane] * lp[64 + lane])) - __expf(wave_sum(lp[128 + lane] * lp[192 + lane])) + LAM_INIT;
    const float g0 = a.in[20][lane] * (1.0f - LAM_INIT), g1 = a.in[20][64 + lane] * (1.0f - LAM_INIT);
    const float* OT = (const float*)(a.ws + WS_OT); bf16_t* O = (bf16_t*)(a.ws + WS_O);
    for (int row = gw; row < MTOK; row += NGW) {
#pragma unroll 4
        for (int h = 0; h < 16; ++h) {
            const float* p1 = OT + (size_t)row * 4096 + (2 * h) * 128; const float* p2 = p1 + 128;
            const float oa = p1[lane] - lam * p2[lane], ob = p1[64 + lane] - lam * p2[64 + lane];
            const float rstd = 1.0f / sqrtf(wave_sum(oa * oa + ob * ob) * (1.f / 128.f) + LN_EPS);
            O[(size_t)row * DM + h * 128 + lane] = f2bf(oa * rstd * g0); O[(size_t)row * DM + h * 128 + 64 + lane] = f2bf(ob * rstd * g1);
        }
    }
}
__device__ __forceinline__ void attn_a(const Args& a, char* lds, int vcu, int G) {
    const att::bf16* QKV = (const att::bf16*)(a.ws + WS_QKV); const att::bf16* KA = (const att::bf16*)(a.ws + WS_KA); const att::bf16* VA = (const att::bf16*)(a.ws + WS_VA);
    att::bf16* O = (att::bf16*)(a.ws + WS_O);
    for (int u = vcu; u < 512; u += G) {
        if (u < 256) { const int b = u >> 7, h = (u >> 3) & 15, qt = u & 7; const size_t qrow = 4096 + (size_t)b * 2048 + qt * 256, krow = 4096 + (size_t)b * 2304;
            att::attn_dense_body<128, att::bf16>(QKV + qrow * NQKV_A + h * 128, NQKV_A, KA + krow * 512 + (h >> 2) * 128, 512, VA + krow * 512 + (h >> 2) * 128, 512, O + qrow * DM + h * 128, DM, 2304, lds); }
        else { const int v = u - 256, b = v >> 4, h = v & 15; const size_t qrow = (size_t)b * 256;
            att::attn_dense_body<128, att::bf16>(QKV + qrow * NQKV_A + h * 128, NQKV_A, KA + qrow * 512 + (h >> 2) * 128, 512, VA + qrow * 512 + (h >> 2) * 128, 512, O + qrow * DM + h * 128, DM, 256, lds); }
    }
}
__device__ __forceinline__ void attn_b(const Args& a, char* lds, int vcu, int G) {
    const att::bf16* QKV = (const att::bf16*)(a.ws + WS_QKV); const att::bf16* KB = (const att::bf16*)(a.ws + WS_KB); const att::bf16* VB = (const att::bf16*)(a.ws + WS_VB);
    float* OT = (float*)(a.ws + WS_OT);
    for (int u = vcu; u < 1024; u += G) {
        if (u < 512) { const int b = u >> 8, hp = (u >> 3) & 31, qt = u & 7; const size_t qrow = 4096 + (size_t)b * 2048 + qt * 256, krow = 4096 + (size_t)b * 2304;
            att::attn_dense_body<64, float>(QKV + qrow * NQKV_B + hp * 64, NQKV_B, KB + krow * 2048 + hp * 64, 2048, VB + krow * 2048 + (hp >> 1) * 128, 2048, OT + qrow * 4096 + hp * 128, 4096, 2304, lds); }
        else { const int v = u - 512, b = v >> 5, hp = v & 31; const size_t qrow = (size_t)b * 256;
            att::attn_dense_body<64, float>(QKV + qrow * NQKV_B + hp * 64, NQKV_B, KB + qrow * 2048 + hp * 64, 2048, VB + qrow * 2048 + (hp >> 1) * 128, 2048, OT + qrow * 4096 + hp * 128, 4096, 256, lds); }
    }
}

__global__ void __launch_bounds__(NTHREADS, 2) mega_fwd(Args a) {
    extern __shared__ __attribute__((aligned(16))) unsigned char lds_raw[];
    LAS unsigned char* lds = (LAS unsigned char*)lds_raw;
    cg::grid_group grid = cg::this_grid();
    const int G = gridDim.x, bx = blockIdx.x;
    const int vcu = (G % 8 == 0) ? (bx % 8) * (G / 8) + bx / 8 : bx;
    const float* MOD = (const float*)(a.ws + WS_MOD);
    int ph = 0;
#define RUN(...) do { if (ph >= a.ph_lo && ph < a.ph_hi) { __VA_ARGS__; if (ph + 1 < a.ph_hi) { __threadfence(); grid.sync(); } } ++ph; } while (0)

    RUN({ p0_gemv(a, lds, G); p0_convert(a, lds, G); });
    RUN(ln_phase(a, true, nullptr, nullptr, MOD, G));
    for (int l = 0; l < 2; ++l) {
        for (int s = 0; s < 3; ++s) {
            const float* modl = MOD + (size_t)l * 3 * NMOD;
            if (s != 1) {
                const int w = l * 2 + (s >> 1);
                RUN({ pg8::Gemm g{(const bf16_t*)(a.ws + WS_H), (const bf16_t*)(a.ws + WS_WIN + w * SZ_WIN), MTOK, 2 * DFF, DM};
                      pg8::StaticOrder S; S.init(MTOK, 2 * DFF, G, bx);
                      pg8::EpiSwiglu E{(bf16_t*)(a.ws + WS_ACT), DFF};
                      pg8::gemm_phase<pg8::EpiSwiglu, pg8::StaticOrder, true, true>(lds, g, S, E); });
                RUN({ pg8::Gemm g{(const bf16_t*)(a.ws + WS_ACT), (const bf16_t*)(a.ws + WS_WOUT + w * SZ_WOUT), MTOK, DM, DFF};
                      pg8::StaticOrder S; S.init(MTOK, DM, G, bx);
                      pg8::EpiRes E{a.out + OUT_X, modl + s * 3 * DM + 2 * DM, NMOD, ALPHA, 0.5f};
                      pg8::gemm_phase<pg8::EpiRes, pg8::StaticOrder, true, true>(lds, g, S, E); });
            } else {
                const int nq = l == 0 ? NQKV_A : NQKV_B;
                RUN({ pg8::Gemm g{(const bf16_t*)(a.ws + WS_H), (const bf16_t*)(a.ws + (l == 0 ? WS_WQA : WS_WQB)), MTOK, nq, DM};
                      pg8::StaticOrder S; S.init(MTOK, nq, G, bx);
                      pg8::EpiPlain E{(bf16_t*)(a.ws + WS_QKV), nq};
                      pg8::gemm_phase<pg8::EpiPlain, pg8::StaticOrder, true, true>(lds, g, S, E); });
                if (l == 0) {
                    RUN(normrope_a(a, G));
                    RUN(attn_a(a, (char*)lds_raw, vcu, G));
                } else {
                    RUN(normrope_b(a, G));
                    RUN(attn_b(a, (char*)lds_raw, vcu, G));
                    RUN(combine_b(a, G));
                }
                RUN({ pg8::Gemm g{(const bf16_t*)(a.ws + WS_O), (const bf16_t*)(a.ws + (l == 0 ? WS_WOA : WS_WOB)), MTOK, DM, DM};
                      pg8::StaticOrder S; S.init(MTOK, DM, G, bx);
                      pg8::EpiRes E{a.out + OUT_X, modl + s * 3 * DM + 2 * DM, NMOD, ALPHA, 1.0f};
                      pg8::gemm_phase<pg8::EpiRes, pg8::StaticOrder, true, true>(lds, g, S, E); });
            }
            const float* nmod = s < 2 ? modl + (s + 1) * 3 * DM : (l == 0 ? MOD + (size_t)3 * NMOD : nullptr);
            RUN(ln_phase(a, false, a.in[10] + (size_t)(l * 3 + s) * DM, a.in[11] + (size_t)(l * 3 + s) * DM, nmod, G));
        }
    }
#undef RUN
}
constexpr int N_PHASES = 2 + 3 + 3 + 4 + 3 + 3 + 5 + 3 + 1;

#ifndef MK_MULTI
#define MK_MULTI 0
#endif
extern "C" void kernel_launch(void* const* d_in, const int* in_sizes, int n_in, void* d_out, int out_size, void* d_ws, size_t ws_size, hipStream_t stream) {
    static int grid = 0;
    if (grid == 0) {
        if (n_in != 22 || ws_size < WS_END || out_size != (int)(OUT_NBV + (size_t)NCTX * 2048)) { fprintf(stderr, "kernel_launch: unexpected shapes (n_in %d, out %d, ws %zu need %zu)\n", n_in, out_size, ws_size, (size_t)WS_END); grid = -1; return; }
        int dev = 0, cus = 0, per_cu = 0;
        hipGetDevice(&dev); hipDeviceGetAttribute(&cus, hipDeviceAttributeMultiprocessorCount, dev);
        if (hipFuncSetAttribute((const void*)mega_fwd, hipFuncAttributeMaxDynamicSharedMemorySize, LDS_BYTES) != hipSuccess) { fprintf(stderr, "kernel_launch: hipFuncSetAttribute failed\n"); grid = -1; return; }
        if (hipOccupancyMaxActiveBlocksPerMultiprocessor(&per_cu, (const void*)mega_fwd, NTHREADS, LDS_BYTES) != hipSuccess || per_cu < 1) { fprintf(stderr, "kernel_launch: occupancy query gives %d\n", per_cu); per_cu = 1; }
        (void)hipGetLastError();
        grid = cus * 1;
    }
    if (grid < 0) return;
    Args a{};
    for (int i = 0; i < 22; ++i) a.in[i] = (const float*)d_in[i];
    a.out = (float*)d_out; a.ws = (unsigned char*)d_ws;
#if MK_MULTI
    for (int p = 0; p < 25; ++p) { a.ph_lo = p; a.ph_hi = p + 1; hipLaunchKernelGGL(mega_fwd, dim3(grid), dim3(NTHREADS), LDS_BYTES, stream, a); }
#else
    a.ph_lo = 0; a.ph_hi = 1000;
    void* args[] = {&a};
    hipError_t e = hipLaunchCooperativeKernel((const void*)mega_fwd, dim3(grid), dim3(NTHREADS), args, LDS_BYTES, stream);
    if (e != hipSuccess) fprintf(stderr, "kernel_launch: cooperative launch failed: %s (grid %d)\n", hipGetErrorString(e), grid);
#endif
}
```

```cpp
#include <hip/hip_runtime.h>
#include <hip/hip_bf16.h>
#include <hip/hip_cooperative_groups.h>
#include <cstdio>
#include <cstdint>
__device__ __forceinline__ int fresh_tid() { int t = threadIdx.x; asm volatile("" : "+v"(t)); return t; }
namespace pg8 {
#define PG8_LAS __attribute__((address_space(3)))
typedef unsigned short bf16_t;
typedef short bf16x8 __attribute__((ext_vector_type(8)));
typedef float f32x4 __attribute__((ext_vector_type(4)));
typedef unsigned u32x4 __attribute__((ext_vector_type(4)));
constexpr int BM = 256, BK = 64, HALF = 128, HTB = HALF * BK * 2  , STAGE_BYTES = 8 * HTB, NXCD = 8, WGM = 8;

__host__ __device__ __forceinline__ int lds_byte(int r, int c) { const int st = (r >> 4) * 2 + (c >> 5), rr = r & 15, cc = c & 31, ob = rr * 64 + cc * 2; return st * 1024 + (ob ^ (((ob >> 9) & 1) << 5)); }
__host__ __device__ __forceinline__ void stage_rc(int b, int& R, int& C) { const int st = b / 1024, sb = b % 1024, swz = sb ^ (((sb >> 9) & 1) << 5); R = (st >> 1) * 16 + swz / 64; C = (st & 1) * 32 + (swz % 64) / 2; }
__host__ __device__ __forceinline__ int perm32(int rho) { const int n = rho >> 4, i = rho & 15; return 8 * (i >> 2) + 4 * n + (i & 3); }

struct Unit { int pm, pn; };
struct Gemm { const bf16_t* A; const bf16_t* Bt; int M, N, K; };

struct StaticOrder {
    int nM, nN, nwg, G, c;
    __host__ __device__ void init(int M, int N, int G_, int c_) { nM = M / BM; nN = N / BM; nwg = nM * nN; G = G_; c = c_; }
    __host__ __device__ bool next(int i, Unit& u) const {
        const long L = (long)i * G + c; if (L >= nwg) return false;
        int wgid = (int)L; { const int q = nwg / NXCD, r = nwg % NXCD, xcd = wgid % NXCD, off = wgid / NXCD; wgid = (xcd < r ? xcd * (q + 1) : r * (q + 1) + (xcd - r) * q) + off; }
        const int nig = WGM * nN, gid = wgid / nig, fm = gid * WGM, gsz = (nM - fm) < WGM ? (nM - fm) : WGM;
        u.pm = fm + ((wgid % nig) % gsz); u.pn = (wgid % nig) / gsz; return true;
    }
    __device__ __forceinline__ void a_ready(const Unit&) const {}
    __device__ __forceinline__ void done(const Unit&) const {}
};

__device__ __forceinline__ unsigned cvt_pk_bf16(float lo, float hi) { unsigned r; asm volatile("v_cvt_pk_bf16_f32 %0, %1, %2" : "=v"(r) : "v"(lo), "v"(hi)); return r; }
typedef float f32x2 __attribute__((ext_vector_type(2)));
__device__ __forceinline__ float silu_f(float g) { return g * __builtin_amdgcn_rcpf(1.0f + __builtin_amdgcn_exp2f(-1.4426950408889634f * g)); }
struct EpiSwiglu {
    static constexpr bool PERM = true, AFTER_DRAIN = false;
    bf16_t* O; int ldc;
    __device__ __forceinline__ void operator()(const f32x4 (&acc)[2][2][4][2], const Unit& u, int wr, int wc, int fr, int fq) const {
        const int row0 = u.pm * BM + wr * 64 + fr, col0 = u.pn * HALF + wc * 32 + 8 * fq;
#pragma unroll
        for (int ai = 0; ai < 2; ++ai)
#pragma unroll
            for (int m = 0; m < 4; ++m) {
                bf16_t* rowp = O + (size_t)(row0 + ai * HALF + m * 16) * ldc + col0;
                const f32x4 g0 = acc[ai][0][m][0], g1 = acc[ai][0][m][1], u0 = acc[ai][1][m][0], u1 = acc[ai][1][m][1];
                u32x4 w;
                w.x = cvt_pk_bf16(silu_f(g0[0]) * u0[0], silu_f(g0[1]) * u0[1]); w.y = cvt_pk_bf16(silu_f(g0[2]) * u0[2], silu_f(g0[3]) * u0[3]);
                w.z = cvt_pk_bf16(silu_f(g1[0]) * u1[0], silu_f(g1[1]) * u1[1]); w.w = cvt_pk_bf16(silu_f(g1[2]) * u1[2], silu_f(g1[3]) * u1[3]);
                *(u32x4*)rowp = w;
            }
    }
};
struct EpiPlain {
    static constexpr bool PERM = true, AFTER_DRAIN = false;
    bf16_t* O; int ldc;
    __device__ __forceinline__ void operator()(const f32x4 (&acc)[2][2][4][2], const Unit& u, int wr, int wc, int fr, int fq) const {
        const int row0 = u.pm * BM + wr * 64 + fr, col0 = u.pn * BM + wc * 32 + 8 * fq;
#pragma unroll
        for (int ai = 0; ai < 2; ++ai)
#pragma unroll
            for (int m = 0; m < 4; ++m) {
                bf16_t* rowp = O + (size_t)(row0 + ai * HALF + m * 16) * ldc + col0;
#pragma unroll
                for (int bj = 0; bj < 2; ++bj) {
                    const f32x4 v0 = acc[ai][bj][m][0], v1 = acc[ai][bj][m][1];
                    u32x4 w; w.x = cvt_pk_bf16(v0[0], v0[1]); w.y = cvt_pk_bf16(v0[2], v0[3]); w.z = cvt_pk_bf16(v1[0], v1[1]); w.w = cvt_pk_bf16(v1[2], v1[3]);
                    *(u32x4*)(rowp + bj * HALF) = w;
                }
            }
    }
};
struct EpiRes {
    static constexpr bool PERM = false, AFTER_DRAIN = false;
    const float* X; float* Xo; const float* gate;   int gate_stride; float alpha, gs;
    __device__ __forceinline__ void operator()(const f32x4 (&acc)[2][2][4][2], const Unit& u, int wr, int wc, int fr, int fq) const {
        const int cidx = u.pm < 16 ? 0 : (u.pm < 24 ? 1 : 2);
        const int row0 = u.pm * BM + wr * 64 + fr, col0 = u.pn * BM + wc * 32 + 4 * fq;
        const float* gp = gate + (size_t)cidx * gate_stride + col0;
        f32x4 gv[2][2];
#pragma unroll
        for (int bj = 0; bj < 2; ++bj)
#pragma unroll
            for (int n = 0; n < 2; ++n) gv[bj][n] = *(const f32x4*)(gp + bj * HALF + n * 16) * gs;
#pragma unroll
        for (int ai = 0; ai < 2; ++ai)
#pragma unroll
            for (int m = 0; m < 4; ++m) {
                const size_t ro = (size_t)(row0 + ai * HALF + m * 16) * 2048 + col0; const float* rowp = X + ro; float* rowo = Xo + ro;
#pragma unroll
                for (int bj = 0; bj < 2; ++bj)
#pragma unroll
                    for (int n = 0; n < 2; ++n) {
                        const f32x4 x = *(const f32x4*)(rowp + bj * HALF + n * 16);
                        *(f32x4*)(rowo + bj * HALF + n * 16) = x * alpha + gv[bj][n] * acc[ai][bj][m][n];
                    }
                if (m & 1) asm volatile("" ::: "memory");
            }
    }
};
template <class Epi, class Sched, bool ALIGN_EPI = false, bool SP2 = false>
__device__ __forceinline__ void gemm_phase(PG8_LAS unsigned char* lds, const Gemm g, const Sched& S, const Epi& E) {
    const int tid = fresh_tid(), wid = __builtin_amdgcn_readfirstlane(tid >> 6), lane = tid & 63, wr = wid >> 2, wc = wid & 3, fr = lane & 15, fq = lane >> 4;
    const int K = g.K, nt = K / BK;
    unsigned voffA[2], voffB[2];
#pragma unroll
    for (int i = 0; i < 2; ++i) { int R, C; stage_rc(tid * 16 + i * 8192, R, C); const int Rb = Epi::PERM ? ((R & ~31) + perm32(R & 31)) : R;
        voffA[i] = (unsigned)(R * K + C) * 2u; voffB[i] = (unsigned)(Rb * K + C) * 2u; }
    const size_t kstep = (size_t)(BK * 2);
    const size_t hstep = (size_t)HALF * K * 2;
    const size_t tstep = 2 * hstep;
    const unsigned ldsw = (unsigned)wid * 1024u;
    const int aoff = lds_byte(wr * 64 + fr, fq * 8), boff = lds_byte(wc * 32 + fr, fq * 8);
#define PG8_SA(b, h) (((b) * 2 + (h)) * HTB)
#define PG8_SB(b, h) ((4 + (b) * 2 + (h)) * HTB)
#define PG8_STAGE(bufoff, gbase, voff) do { _Pragma("unroll") for (int _i = 0; _i < 2; ++_i) \
        __builtin_amdgcn_global_load_lds((const unsigned*)((const char*)(gbase) + (voff)[_i]), (PG8_LAS unsigned*)(lds + (bufoff) + ldsw + _i * 8192), 16, 0, 0); } while (0)
#define PG8_LDA(dst, b, h) do { _Pragma("unroll") for (int m = 0; m < 4; ++m) _Pragma("unroll") for (int k = 0; k < 2; ++k) dst[m][k] = *(const PG8_LAS bf16x8*)(lds + PG8_SA(b, h) + aoff + m * 2048 + k * 1024); } while (0)
#define PG8_LDB(dst, b, h) do { _Pragma("unroll") for (int n = 0; n < 2; ++n) _Pragma("unroll") for (int k = 0; k < 2; ++k) dst[n][k] = *(const PG8_LAS bf16x8*)(lds + PG8_SB(b, h) + boff + n * 2048 + k * 1024); } while (0)
#define PG8_MMA(ai, bj, At, Bt) do { __builtin_amdgcn_s_setprio(1); _Pragma("unroll") for (int m = 0; m < 4; ++m) _Pragma("unroll") for (int n = 0; n < 2; ++n) _Pragma("unroll") for (int k = 0; k < 2; ++k) \
        acc[ai][bj][m][n] = __builtin_amdgcn_mfma_f32_16x16x32_bf16(Bt[n][k], At[m][k], acc[ai][bj][m][n], 0, 0, 0); __builtin_amdgcn_s_setprio(0); } while (0)
#define PG8_WAIT_V(n) asm volatile("s_waitcnt vmcnt(" #n ")" ::: "memory")
#define PG8_WAIT_L(n) asm volatile("s_waitcnt lgkmcnt(" #n ")" ::: "memory")
#define PG8_BAR __builtin_amdgcn_s_barrier()
#define PG8_SCHED __builtin_amdgcn_sched_barrier(0)
    Unit cur, nxt; int ui = 0;
    if (!S.next(0, cur)) return;
    f32x4 acc[2][2][4][2];
#pragma unroll
    for (int a = 0; a < 2; ++a)
#pragma unroll
        for (int b = 0; b < 2; ++b)
#pragma unroll
            for (int m = 0; m < 4; ++m)
#pragma unroll
                for (int n = 0; n < 2; ++n) acc[a][b][m][n] = (f32x4){0.f, 0.f, 0.f, 0.f};
    bf16x8 At[4][2], B0[2][2], B1[2][2];
    const char* cA = (const char*)g.A + (size_t)cur.pm * tstep; const char* cB = (const char*)g.Bt + (size_t)cur.pn * tstep;
    S.a_ready(cur);
    if constexpr (SP2) {
        PG8_STAGE(PG8_SB(0, 0), cB, voffB); PG8_STAGE(PG8_SB(0, 1), cB + hstep, voffB); PG8_STAGE(PG8_SA(0, 0), cA, voffA); PG8_STAGE(PG8_SA(0, 1), cA + hstep, voffA);
        if (wr == 1) PG8_BAR;
        PG8_WAIT_V(2); PG8_BAR;
        PG8_STAGE(PG8_SB(1, 0), cB + kstep, voffB); PG8_STAGE(PG8_SA(1, 0), cA + kstep, voffA); PG8_STAGE(PG8_SB(1, 1), cB + hstep + kstep, voffB);
        PG8_WAIT_V(6); PG8_BAR;
    } else {
        PG8_STAGE(PG8_SB(0, 0), cB, voffB); PG8_STAGE(PG8_SA(0, 0), cA, voffA); PG8_STAGE(PG8_SB(0, 1), cB + hstep, voffB); PG8_STAGE(PG8_SA(0, 1), cA + hstep, voffA);
        if (wr == 1) PG8_BAR;
        PG8_WAIT_V(4); PG8_BAR;
        PG8_STAGE(PG8_SB(1, 0), cB + kstep, voffB); PG8_STAGE(PG8_SA(1, 0), cA + kstep, voffA); PG8_STAGE(PG8_SB(1, 1), cB + hstep + kstep, voffB);
        PG8_WAIT_V(6); PG8_BAR;
    }
    for (;;) {
        const bool has_next = S.next(ui + 1, nxt);
        const char* nA = has_next ? (const char*)g.A + (size_t)nxt.pm * tstep : cA; const char* nB = has_next ? (const char*)g.Bt + (size_t)nxt.pn * tstep : cB;
        for (int t = 0; t < nt; t += 2) {
            const bool last = (t == nt - 2);
            const char* a1 = cA + (size_t)(t + 1) * kstep;
            const char* a2 = last ? nA : cA + (size_t)(t + 2) * kstep; const char* b2 = last ? nB : cB + (size_t)(t + 2) * kstep;
            const char* a3 = a2 + kstep; const char* b3 = b2 + kstep;
            if (last && has_next) S.a_ready(nxt);
            if constexpr (SP2) {
            PG8_LDB(B0, 0, 0); PG8_LDB(B1, 0, 1); PG8_SCHED; PG8_LDA(At, 0, 0); PG8_STAGE(PG8_SA(1, 1), a1 + hstep, voffA);
            PG8_WAIT_V(8); PG8_WAIT_L(0); PG8_BAR; PG8_MMA(0, 0, At, B0); PG8_MMA(0, 1, At, B1); PG8_BAR; PG8_SCHED;
            PG8_LDA(At, 0, 1); PG8_STAGE(PG8_SB(0, 0), b2, voffB); PG8_STAGE(PG8_SB(0, 1), b2 + hstep, voffB); PG8_STAGE(PG8_SA(0, 0), a2, voffA);
            PG8_WAIT_V(8); PG8_WAIT_L(0); PG8_BAR; PG8_MMA(1, 0, At, B0); PG8_MMA(1, 1, At, B1); PG8_BAR; PG8_SCHED;
            PG8_LDB(B0, 1, 0); PG8_LDB(B1, 1, 1); PG8_SCHED; PG8_LDA(At, 1, 0); PG8_STAGE(PG8_SA(0, 1), a2 + hstep, voffA);
            PG8_WAIT_V(8); PG8_WAIT_L(0); PG8_BAR; PG8_MMA(0, 0, At, B0); PG8_MMA(0, 1, At, B1); PG8_BAR; PG8_SCHED;
            PG8_LDA(At, 1, 1); PG8_STAGE(PG8_SB(1, 0), b3, voffB); PG8_STAGE(PG8_SB(1, 1), b3 + hstep, voffB); PG8_STAGE(PG8_SA(1, 0), a3, voffA);
            PG8_WAIT_V(8); PG8_WAIT_L(0); PG8_BAR; PG8_MMA(1, 0, At, B0); PG8_MMA(1, 1, At, B1); PG8_BAR; PG8_SCHED;
            } else {
            PG8_LDB(B0, 0, 0); PG8_SCHED; PG8_LDA(At, 0, 0); PG8_STAGE(PG8_SA(1, 1), a1 + hstep, voffA);
            PG8_WAIT_L(8); PG8_BAR; PG8_WAIT_L(0); PG8_MMA(0, 0, At, B0); PG8_BAR; PG8_SCHED;
            PG8_LDB(B1, 0, 1); PG8_STAGE(PG8_SB(0, 0), b2, voffB);
            PG8_BAR; PG8_WAIT_L(0); PG8_MMA(0, 1, At, B1); PG8_BAR;
            PG8_LDA(At, 0, 1); PG8_STAGE(PG8_SA(0, 0), a2, voffA);
            PG8_BAR; PG8_WAIT_L(0); PG8_MMA(1, 0, At, B0); PG8_BAR; PG8_SCHED;
            PG8_STAGE(PG8_SB(0, 1), b2 + hstep, voffB);
            PG8_WAIT_V(6); PG8_BAR; PG8_MMA(1, 1, At, B1); PG8_BAR;
            PG8_LDB(B0, 1, 0); PG8_SCHED; PG8_LDA(At, 1, 0); PG8_STAGE(PG8_SA(0, 1), a2 + hstep, voffA);
            PG8_WAIT_L(8); PG8_BAR; PG8_WAIT_L(0); PG8_MMA(0, 0, At, B0); PG8_BAR; PG8_SCHED;
            PG8_LDB(B1, 1, 1); PG8_STAGE(PG8_SB(1, 0), b3, voffB);
            PG8_BAR; PG8_WAIT_L(0); PG8_MMA(0, 1, At, B1); PG8_BAR;
            PG8_LDA(At, 1, 1); PG8_STAGE(PG8_SA(1, 0), a3, voffA);
            PG8_BAR; PG8_WAIT_L(0); PG8_MMA(1, 0, At, B0); PG8_BAR; PG8_SCHED;
            PG8_STAGE(PG8_SB(1, 1), b3 + hstep, voffB);
            PG8_WAIT_V(6); PG8_BAR; PG8_MMA(1, 1, At, B1); PG8_BAR;
            }
        }
        if constexpr (ALIGN_EPI) { if (wr == 0) PG8_BAR; }
        if constexpr (!Epi::AFTER_DRAIN) { E(acc, cur, wr, wc, fr, fq); S.done(cur); }
        if (!has_next) break;
#pragma unroll
        for (int a = 0; a < 2; ++a)
#pragma unroll
            for (int b = 0; b < 2; ++b)
#pragma unroll
                for (int m = 0; m < 4; ++m)
#pragma unroll
                    for (int n = 0; n < 2; ++n) acc[a][b][m][n] = (f32x4){0.f, 0.f, 0.f, 0.f};
        cur = nxt; cA = nA; cB = nB; ++ui;
        if constexpr (ALIGN_EPI) { if (wr == 1) PG8_BAR; }
    }
    PG8_WAIT_V(0);
    if constexpr (!ALIGN_EPI) { if (wr == 0) PG8_BAR; }
    PG8_BAR;
    if constexpr (Epi::AFTER_DRAIN) { E.fused(acc, cur, wr, wc, fr, fq, lds, wid, lane); S.done(cur); }
#undef PG8_SA
#undef PG8_SB
#undef PG8_STAGE
#undef PG8_LDA
#undef PG8_LDB
#undef PG8_MMA
#undef PG8_WAIT_V
#undef PG8_WAIT_L
#undef PG8_BAR
#undef PG8_SCHED
}
}
namespace att {
using bf16 = __hip_bfloat16;
constexpr int DV = 128, NW = 8, QBLK = 32, KVBLK = 64;
constexpr float THR = 8.f;
constexpr size_t SHM_V = KVBLK * DV * 2, SHM_K = KVBLK * 128 * 2, SHM_ATTN = 2 * SHM_V + 2 * SHM_K + NW * 64 * 4;
using bf16x8 = __attribute__((ext_vector_type(8))) short;
using s16x4  = __attribute__((ext_vector_type(4))) short;
using f32x16 = __attribute__((ext_vector_type(16))) float;
using u32x4  = __attribute__((ext_vector_type(4))) unsigned;
#define KSWZ(row, colB) ((row) * 256 + ((colB) ^ (((row) & 7) << 4)))
#define KSWZ64(row, colB) ((row) * 128 + ((colB) ^ (((row) & 7) << 4)))
#define SBAR() __builtin_amdgcn_sched_barrier(0)
template <int DQK> __device__ __forceinline__ constexpr float scale_of() { return DQK == 128 ? 0.088388347648318440f : 0.125f; }
__device__ __forceinline__ int crow(int r, int hi) { return (r & 3) + 8 * (r >> 2) + 4 * hi; }
__device__ __forceinline__ unsigned cvtpk(float lo, float hi) { unsigned r; asm volatile("v_cvt_pk_bf16_f32 %0, %1, %2" : "=v"(r) : "v"(lo), "v"(hi)); return r; }

template <int DQK>
__device__ __forceinline__ void partialSM(f32x16& p0, f32x16& p1, float& m_reg, float& mn, float& alpha) {
  constexpr float SCALE = scale_of<DQK>();
  constexpr float C = SCALE * 1.4426950408889634f;
  float pmax = p0[0];
#pragma unroll
  for (int r = 1; r < 16; ++r) pmax = fmaxf(pmax, p0[r]);
#pragma unroll
  for (int r = 0; r < 16; ++r) pmax = fmaxf(pmax, p1[r]);
  { auto rr = __builtin_amdgcn_permlane32_swap(__float_as_uint(pmax), __float_as_uint(pmax), false, false);
    pmax = fmaxf(__uint_as_float(rr[0]), __uint_as_float(rr[1])); }
  if (__builtin_expect(__all(pmax - m_reg <= THR / SCALE), 1)) { mn = m_reg; alpha = 1.f; }
  else { mn = fmaxf(m_reg, pmax); alpha = __builtin_amdgcn_exp2f((m_reg - mn) * C); m_reg = mn; }
  float mnC = -mn * C;
#pragma unroll
  for (int r = 0; r < 16; ++r) p0[r] = fmaf(p0[r], C, mnC);
#pragma unroll
  for (int r = 0; r < 16; ++r) p1[r] = fmaf(p1[r], C, mnC);
#pragma unroll
  for (int r = 0; r < 16; ++r) p0[r] = __builtin_amdgcn_exp2f(p0[r]);
}
__device__ __forceinline__ void finishSM(f32x16& p0, f32x16& p1, float alpha, float& l_reg, bf16x8& pa0, bf16x8& pa1, bf16x8& pa2, bf16x8& pa3) {
#pragma unroll
  for (int r = 0; r < 16; ++r) p1[r] = __builtin_amdgcn_exp2f(p1[r]);
  float ps = 0;
#pragma unroll
  for (int r = 0; r < 16; ++r) ps += p0[r];
#pragma unroll
  for (int r = 0; r < 16; ++r) ps += p1[r];
  { auto rr = __builtin_amdgcn_permlane32_swap(__float_as_uint(ps), __float_as_uint(ps), false, false);
    ps = __uint_as_float(rr[0]) + __uint_as_float(rr[1]); }
  l_reg = l_reg * alpha + ps;
#define PK4(P, BASE, OUT) do { unsigned a0 = cvtpk(P[BASE + 0], P[BASE + 1]), a1 = cvtpk(P[BASE + 2], P[BASE + 3]);   \
    unsigned b0 = cvtpk(P[BASE + 4], P[BASE + 5]), b1 = cvtpk(P[BASE + 6], P[BASE + 7]);                              \
    auto r0 = __builtin_amdgcn_permlane32_swap(a0, b0, false, false); auto r1 = __builtin_amdgcn_permlane32_swap(a1, b1, false, false); \
    u32x4 w = {r0[0], r1[0], r0[1], r1[1]}; OUT = *reinterpret_cast<bf16x8*>(&w); } while (0)
  PK4(p0, 0, pa0); PK4(p0, 8, pa1); PK4(p1, 0, pa2); PK4(p1, 8, pa3);
#undef PK4
}
template <int DQK>
__device__ __forceinline__ void qkt(f32x16& p0, f32x16& p1, const bf16* Ks, const bf16x8* qr, int r32, int hi) {
  p0 = f32x16{}; p1 = f32x16{};
#pragma unroll
  for (int d0 = 0; d0 < DQK / 16; ++d0) { int cb = (d0 * 16 + hi * 8) * 2;
    bf16x8 b0, b1;
    if constexpr (DQK == 128) { b0 = *reinterpret_cast<const bf16x8*>((const char*)Ks + KSWZ(r32, cb)); b1 = *reinterpret_cast<const bf16x8*>((const char*)Ks + KSWZ(32 + r32, cb)); }
    else { b0 = *reinterpret_cast<const bf16x8*>((const char*)Ks + KSWZ64(r32, cb)); b1 = *reinterpret_cast<const bf16x8*>((const char*)Ks + KSWZ64(32 + r32, cb)); }
    p0 = __builtin_amdgcn_mfma_f32_32x32x16_bf16(b0, qr[d0], p0, 0, 0, 0);
    p1 = __builtin_amdgcn_mfma_f32_32x32x16_bf16(b1, qr[d0], p1, 0, 0, 0); }
}
__device__ __forceinline__ int v_st(int k, int c) { const int kk = (k & ~0xC) | ((k & 4) << 1) | ((k & 8) >> 1); return ((kk >> 3) * 4 + (c >> 5)) * 512 + ((kk & 7) * 32 + (c & 31)) * 2; }
__device__ __forceinline__ int v_rd_base(int lane) { return ((lane & 3) << 3) | (((lane >> 2) & 3) << 6) | (((lane >> 4) & 1) << 5) | (((lane >> 5) & 1) << 8); }
constexpr int v_rd_off(int d0, int ks, int half) { return d0 * 512 + ks * 4096 + half * 2048; }
template <int OFF> __device__ __forceinline__ s16x4 tr_read(int vb) {
  s16x4 r; asm volatile("ds_read_b64_tr_b16 %0, %1 offset:%2" : "=&v"(r) : "v"(vb), "i"(OFF) : "memory"); return r;
}
template <int D0> __device__ __forceinline__ void pv_one(f32x16& od, int vb, bf16x8 pa0, bf16x8 pa1, bf16x8 pa2, bf16x8 pa3) {
  const s16x4 l0 = tr_read<v_rd_off(D0, 0, 0)>(vb), h0 = tr_read<v_rd_off(D0, 0, 1)>(vb), l1 = tr_read<v_rd_off(D0, 1, 0)>(vb), h1 = tr_read<v_rd_off(D0, 1, 1)>(vb);
  const s16x4 l2 = tr_read<v_rd_off(D0, 2, 0)>(vb), h2 = tr_read<v_rd_off(D0, 2, 1)>(vb), l3 = tr_read<v_rd_off(D0, 3, 0)>(vb), h3 = tr_read<v_rd_off(D0, 3, 1)>(vb);
  asm volatile("s_waitcnt lgkmcnt(0)" ::: "memory"); SBAR();
#define PK(L, H) (bf16x8){L[0], L[1], L[2], L[3], H[0], H[1], H[2], H[3]}
  od = __builtin_amdgcn_mfma_f32_32x32x16_bf16(pa0, PK(l0, h0), od, 0, 0, 0);
  od = __builtin_amdgcn_mfma_f32_32x32x16_bf16(pa1, PK(l1, h1), od, 0, 0, 0);
  od = __builtin_amdgcn_mfma_f32_32x32x16_bf16(pa2, PK(l2, h2), od, 0, 0, 0);
  od = __builtin_amdgcn_mfma_f32_32x32x16_bf16(pa3, PK(l3, h3), od, 0, 0, 0);
#undef PK
}
__device__ __forceinline__ void pv_d0(f32x16* o, int vb, bf16x8 pa0, bf16x8 pa1, bf16x8 pa2, bf16x8 pa3) {
  pv_one<0>(o[0], vb, pa0, pa1, pa2, pa3); pv_one<1>(o[1], vb, pa0, pa1, pa2, pa3); pv_one<2>(o[2], vb, pa0, pa1, pa2, pa3); pv_one<3>(o[3], vb, pa0, pa1, pa2, pa3);
}
__device__ __forceinline__ void store_o(float* p, float v) { *p = v; }
__device__ __forceinline__ void store_o(bf16* p, float v) { *p = __float2bfloat16(v); }

template <int DQK, typename TO>
__device__ __forceinline__ void attn_dense_body(const bf16* __restrict__ Qb, int ldq, const bf16* __restrict__ Kh, int ldk, const bf16* __restrict__ Vh, int ldv,
                                                TO* __restrict__ Ob, int ldo, int seq, char* lds) {
  const int tid = fresh_tid(), wid = tid >> 6, lane = tid & 63, r32 = lane & 31, hi = lane >> 5;
  bf16* V_lds = (bf16*)lds; bf16* K_lds = (bf16*)(lds + 2 * SHM_V);
  float* ws = (float*)(lds + 2 * SHM_V + 2 * SHM_K) + wid * 64; float* li_l = ws; float* al_l = ws + 32;
  float m_reg = -1e30f, l_reg = 0; f32x16 o[4] = {}; bf16x8 qr[DQK / 16];
  const bf16* Qw = Qb + (long)(wid * QBLK + r32) * ldq + hi * 8;
#pragma unroll
  for (int d0 = 0; d0 < DQK / 16; ++d0) qr[d0] = *reinterpret_cast<const bf16x8*>(Qw + d0 * 16);
  const int sr = tid >> 4, sc = (tid & 15) * 8, vst0 = v_st(sr, sc), vst1 = v_st(32 + sr, sc);
  const int kr = (DQK == 128) ? sr : (tid >> 3), kc = (DQK == 128) ? sc : (tid & 7) * 8;
  const int vb0 = (int)(uintptr_t)V_lds + v_rd_base(lane);
  struct { bf16x8 vs0, vs1, ks0, ks1; } sr_[2];
#define SLOAD(i, k0) do { sr_[i].vs0 = *reinterpret_cast<const bf16x8*>(&Vh[(long)((k0) + sr) * ldv + sc]); sr_[i].vs1 = *reinterpret_cast<const bf16x8*>(&Vh[(long)((k0) + 32 + sr) * ldv + sc]); \
    sr_[i].ks0 = *reinterpret_cast<const bf16x8*>(&Kh[(long)((k0) + kr) * ldk + kc]); \
    if constexpr (DQK == 128) sr_[i].ks1 = *reinterpret_cast<const bf16x8*>(&Kh[(long)((k0) + 32 + kr) * ldk + kc]); } while (0)
#define SWRITE(b, i) do { *(bf16x8*)((char*)V_lds + (b) * SHM_V + vst0) = sr_[i].vs0;          \
    *(bf16x8*)((char*)V_lds + (b) * SHM_V + vst1) = sr_[i].vs1; int kcb = kc * 2;               \
    if constexpr (DQK == 128) { *(bf16x8*)((char*)K_lds + (b) * SHM_K + KSWZ(kr, kcb)) = sr_[i].ks0;                       \
      *(bf16x8*)((char*)K_lds + (b) * SHM_K + KSWZ(32 + kr, kcb)) = sr_[i].ks1; }               \
    else { *(bf16x8*)((char*)K_lds + (b) * SHM_K + KSWZ64(kr, kcb)) = sr_[i].ks0; } } while (0)
#define SWAIT() do { if constexpr (DQK == 128) asm volatile("s_waitcnt vmcnt(4)" ::: "memory"); else asm volatile("s_waitcnt vmcnt(3)" ::: "memory"); } while (0)
#define RESC(a) do { if (__any((a) < 1.f)) { if (hi == 0) al_l[r32] = (a); asm volatile("s_waitcnt lgkmcnt(0)" ::: "memory"); \
    _Pragma("unroll") for (int d = 0; d < 4; ++d) _Pragma("unroll") for (int r = 0; r < 16; ++r) o[d][r] *= al_l[crow(r, hi)]; } } while (0)
  f32x16 pA0, pA1, pB0, pB1; float mnA, mnB, alA, alB; bf16x8 pa0, pa1, pa2, pa3; const int NT = seq / KVBLK;
  constexpr int SE = 0, SO = 1;
  SLOAD(SE, 0); asm volatile("s_waitcnt vmcnt(0)" ::: "memory"); SWRITE(0, SE); __syncthreads();
  qkt<DQK>(pA0, pA1, K_lds, qr, r32, hi); partialSM<DQK>(pA0, pA1, m_reg, mnA, alA);
  SLOAD(SO, KVBLK); if (2 < NT) SLOAD(SE, 2 * KVBLK);
  if (2 < NT) { SWAIT(); } else { asm volatile("s_waitcnt vmcnt(0)" ::: "memory"); }
  SWRITE(1, SO); __syncthreads();
  for (int j = 1; j + 1 < NT; j += 2) {
    SBAR(); qkt<DQK>(pB0, pB1, (bf16*)((char*)K_lds + SHM_K), qr, r32, hi);
    finishSM(pA0, pA1, alA, l_reg, pa0, pa1, pa2, pa3); SBAR();
    SLOAD(SO, (j + 2) * KVBLK); SBAR();
    pv_d0(o, vb0, pa0, pa1, pa2, pa3); partialSM<DQK>(pB0, pB1, m_reg, mnB, alB);
    __syncthreads(); SWAIT(); SWRITE(0, SE);
    RESC(alB); __syncthreads();
    SBAR(); qkt<DQK>(pA0, pA1, K_lds, qr, r32, hi);
    finishSM(pB0, pB1, alB, l_reg, pa0, pa1, pa2, pa3); SBAR();
    if (j + 3 < NT) SLOAD(SE, (j + 3) * KVBLK); SBAR();
    pv_d0(o, vb0 + (int)SHM_V, pa0, pa1, pa2, pa3); partialSM<DQK>(pA0, pA1, m_reg, mnA, alA);
    __syncthreads(); if (j + 3 < NT) { SWAIT(); } else { asm volatile("s_waitcnt vmcnt(0)" ::: "memory"); } SWRITE(1, SO);
    RESC(alA); __syncthreads();
  }
  SBAR(); qkt<DQK>(pB0, pB1, (bf16*)((char*)K_lds + SHM_K), qr, r32, hi);
  finishSM(pA0, pA1, alA, l_reg, pa0, pa1, pa2, pa3); SBAR();
  pv_d0(o, vb0, pa0, pa1, pa2, pa3); partialSM<DQK>(pB0, pB1, m_reg, mnB, alB);
  __syncthreads(); RESC(alB);
  finishSM(pB0, pB1, alB, l_reg, pa0, pa1, pa2, pa3); SBAR();
  pv_d0(o, vb0 + (int)SHM_V, pa0, pa1, pa2, pa3);
  if (hi == 0) li_l[r32] = l_reg; asm volatile("s_waitcnt lgkmcnt(0)" ::: "memory");
  float rli[16];
#pragma unroll
  for (int r = 0; r < 16; ++r) rli[r] = __builtin_amdgcn_rcpf(li_l[crow(r, hi)]);
  TO* Ow = Ob + (long)(wid * QBLK) * ldo;
#pragma unroll
  for (int r = 0; r < 16; ++r) { int orow = crow(r, hi);
#pragma unroll
    for (int d0 = 0; d0 < 4; ++d0) store_o(&Ow[(long)orow * ldo + d0 * 32 + r32], o[d0][r] * rli[r]); }
  __syncthreads();
#undef SLOAD
#undef SWRITE
#undef SWAIT
#undef RESC
}
#undef KSWZ
#undef KSWZ64
#undef SBAR
}
namespace cg = cooperative_groups;
#define PROBE 0
#define LAS __attribute__((address_space(3)))
typedef unsigned short bf16_t;
typedef float f32x4 __attribute__((ext_vector_type(4)));
typedef float f32x2 __attribute__((ext_vector_type(2)));
typedef unsigned u32x4 __attribute__((ext_vector_type(4)));
typedef unsigned u32x2 __attribute__((ext_vector_type(2)));

constexpr int NWAVES = 8, NTHREADS = 512;
constexpr int DM = 2048, DFF = 5504, MTOK = 8192, NCTX = 4096;
constexpr int NMOD = 9 * DM;
constexpr int NQKV_A = 3072, NQKV_B = 6144;
constexpr int KVROWS = 4096 + 2 * 2304;
constexpr float LN_EPS = 1e-6f;
constexpr float ALPHA = 1.4142135623730951f;
constexpr float LAM_INIT = 0.35550906759f;
constexpr int LDS_BYTES = 147456;

constexpr size_t al256(size_t x) { return (x + 255) / 256 * 256; }
constexpr size_t WS_BAR = 0, BAR_BYTES = 16384;
constexpr size_t WS_MOD = BAR_BYTES;
constexpr size_t WS_WIN = al256(WS_MOD + (size_t)2 * 3 * NMOD * 4);
constexpr size_t SZ_WIN = (size_t)2 * DFF * DM * 2;
constexpr size_t WS_WOUT = WS_WIN + 4 * SZ_WIN;
constexpr size_t SZ_WOUT = (size_t)DM * DFF * 2;
constexpr size_t WS_WQA = WS_WOUT + 4 * SZ_WOUT;
constexpr size_t WS_WQB = WS_WQA + (size_t)NQKV_A * DM * 2;
constexpr size_t WS_WOA = WS_WQB + (size_t)NQKV_B * DM * 2;
constexpr size_t WS_WOB = WS_WOA + (size_t)DM * DM * 2;
constexpr size_t WS_H = WS_WOB + (size_t)DM * DM * 2;
constexpr size_t WS_ACT = WS_H + (size_t)MTOK * DM * 2;
constexpr size_t WS_QKV = WS_ACT + (size_t)MTOK * DFF * 2;
constexpr size_t WS_KA = WS_QKV + (size_t)MTOK * NQKV_B * 2;
constexpr size_t WS_VA = WS_KA + (size_t)KVROWS * 512 * 2;
constexpr size_t WS_KB = WS_VA + (size_t)KVROWS * 512 * 2;
constexpr size_t WS_VB = WS_KB + (size_t)KVROWS * 2048 * 2;
constexpr size_t WS_O = WS_VB + (size_t)KVROWS * 2048 * 2;
constexpr size_t WS_OT = WS_O + (size_t)MTOK * DM * 2;
constexpr size_t WS_END = WS_OT + (size_t)MTOK * 4096 * 4;

constexpr size_t OUT_X = 0, OUT_NAK = (size_t)MTOK * DM, OUT_NAV = OUT_NAK + (size_t)NCTX * 512, OUT_NBK = OUT_NAV + (size_t)NCTX * 512, OUT_NBV = OUT_NBK + (size_t)NCTX * 2048;

__device__ __forceinline__ float wave_sum(float v) {
#pragma unroll
    for (int o = 1; o < 64; o <<= 1) v += __shfl_xor(v, o);
    return v;
}
__device__ __forceinline__ unsigned pk_bf16(float lo, float hi) { return pg8::cvt_pk_bf16(lo, hi); }
__device__ __forceinline__ float bf2f(bf16_t b) { return __uint_as_float((unsigned)b << 16); }
__device__ __forceinline__ bf16_t f2bf(float f) { return (bf16_t)(pk_bf16(f, 0.f) & 0xffffu); }
#define LDS_WAIT() asm volatile("s_waitcnt lgkmcnt(0)" ::: "memory")

#define XB_TMO      128
#define XB_XCNT(j)  (256  + 64 * (j))
#define XB_XSUB(j)  (1280 + 64 * (j))
#define XB_XGEN(j)  (2304 + 64 * (j))
#define XB_TOP      3328
#define XB_TOPGEN   3392
#define XCD_BAR_WORDS 3456
#define XB_SPIN_CAP (1u << 18)

__device__ __forceinline__ unsigned xb_ld(unsigned* p)              { return __hip_atomic_load(p, __ATOMIC_RELAXED, __HIP_MEMORY_SCOPE_AGENT); }
__device__ __forceinline__ unsigned xb_add(unsigned* p, unsigned v) { return __hip_atomic_fetch_add(p, v, __ATOMIC_RELAXED, __HIP_MEMORY_SCOPE_AGENT); }
__device__ __forceinline__ unsigned xb_xcc_id() { return (unsigned)__builtin_amdgcn_s_getreg((3 << 11) | 20) & 0xFu; }
#define XB_SPIN(cond, bar) do { unsigned _sp = 0; while (cond) { __builtin_amdgcn_s_sleep(1); \
    if ((++_sp & 255u) == 0u) { if (xb_ld(&(bar)[XB_TMO])) break; if (_sp > XB_SPIN_CAP) { atomicAdd(&(bar)[XB_TMO], 1u); break; } } } } while (0)

struct XcdBarrier {
    unsigned* bar; unsigned x;
    volatile LAS unsigned* st;
};

__device__ __forceinline__ XcdBarrier xcd_barrier_post(unsigned* bar, volatile LAS unsigned* st) {
    XcdBarrier b; b.bar = bar; b.x = xb_xcc_id(); b.st = st;
    if (threadIdx.x == 0) (void)xb_add(&bar[XB_XCNT(b.x)], 1u);
    return b;
}
__device__ __forceinline__ void xcd_barrier_complete(unsigned* bar, unsigned x, unsigned& nloc, unsigned& nx) {
    const unsigned G = gridDim.x * gridDim.y * gridDim.z;
    unsigned sum, cnt, mine, sp = 0u;
    for (;;) {
        sum = 0u; cnt = 0u; mine = 0u;
#pragma unroll
        for (unsigned j = 0; j < 16; ++j) { const unsigned c = xb_ld(&bar[XB_XCNT(j)]); sum += c; cnt += (c > 0u) ? 1u : 0u; mine = (j == x) ? c : mine; }
        if (sum == G) break;
        __builtin_amdgcn_s_sleep(1);
        if ((++sp & 255u) == 0u) { if (xb_ld(&bar[XB_TMO])) break; if (sp > XB_SPIN_CAP) { atomicAdd(&bar[XB_TMO], 1u); break; } }
    }
    nloc = mine > 0u ? mine : 1u; nx = cnt > 0u ? cnt : 1u;
}

__device__ __forceinline__ void xcd_barrier(const XcdBarrier& b) {
    asm volatile("s_waitcnt vmcnt(0)" ::: "memory");
    __syncthreads();
    if (threadIdx.x == 0) {
        unsigned* bar = b.bar;
        __builtin_amdgcn_s_waitcnt(0);
        unsigned nloc = b.st[0], nx = b.st[1];
        if (nloc == 0u) { xcd_barrier_complete(bar, b.x, nloc, nx); b.st[0] = nloc; b.st[1] = nx; }
        const unsigned old = xb_add(&bar[XB_XSUB(b.x)], 1u);
        const unsigned gen = old / nloc;
        if (old + 1u == (gen + 1u) * nloc) {
            __builtin_amdgcn_fence(__ATOMIC_RELEASE, "agent");
            asm volatile("s_waitcnt vmcnt(0)" ::: "memory");
            const unsigned og = xb_add(&bar[XB_TOP], 1u);
            const unsigned tg = og / nx;
            if (og + 1u == (tg + 1u) * nx) xb_add(&bar[XB_TOPGEN], 1u);
            else XB_SPIN(xb_ld(&bar[XB_TOPGEN]) == tg, bar);
            __builtin_amdgcn_fence(__ATOMIC_ACQUIRE, "agent");
            xb_add(&bar[XB_XGEN(b.x)], 1u);
            asm volatile("s_waitcnt vmcnt(0)" ::: "memory");
        } else {
            XB_SPIN(xb_ld(&bar[XB_XGEN(b.x)]) == gen, bar);
            __builtin_amdgcn_fence(__ATOMIC_ACQUIRE, "agent");
            asm volatile("s_waitcnt vmcnt(0)" ::: "memory");
        }
    }
    __syncthreads();
}

struct Args { const float* in[22]; float* out; unsigned char* ws; int ph_lo, ph_hi; };

__device__ __forceinline__ void p0_gemv(const Args& a, LAS unsigned char* lds, int G) {
    const int tid = fresh_tid(), lane = tid & 63, wave = tid >> 6;
    LAS float* sc = (LAS float*)lds;
    LAS float* red = sc + 3 * DM;
    const float* c = a.in[6]; const float* cctx = a.in[7];
    for (int i = tid; i < 3 * DM; i += NTHREADS) { const int ci = i / DM, k = i % DM; const float v = ci == 0 ? cctx[k] : c[(ci - 1) * DM + k]; sc[i] = pg8::silu_f(v); }
    __syncthreads();
    float* MOD = (float*)(a.ws + WS_MOD);
    for (int item = blockIdx.x; item < 2 * 144; item += G) {
        const int l = item / 144, cgp = item % 144;
        const float* W = a.in[8] + (size_t)l * DM * NMOD + cgp * 128 + 2 * lane;
        f32x2 acc0 = {0.f, 0.f}, acc1 = {0.f, 0.f}, acc2 = {0.f, 0.f};
        const int kb = wave * 256;
        for (int k = kb; k < kb + 256; k += 8) {
            f32x2 w[8];
#pragma unroll
            for (int i = 0; i < 8; ++i) w[i] = *(const f32x2*)(W + (size_t)(k + i) * NMOD);
#pragma unroll
            for (int i = 0; i < 8; ++i) { acc0 += w[i] * sc[k + i]; acc1 += w[i] * sc[DM + k + i]; acc2 += w[i] * sc[2 * DM + k + i]; }
        }
        *(LAS f32x2*)(red + (wave * 3 + 0) * 128 + 2 * lane) = acc0;
        *(LAS f32x2*)(red + (wave * 3 + 1) * 128 + 2 * lane) = acc1;
        *(LAS f32x2*)(red + (wave * 3 + 2) * 128 + 2 * lane) = acc2;
        __syncthreads();
        if (tid < 384) { const int ci = tid >> 7, j = tid & 127; float s = 0.f;
#pragma unroll
            for (int w = 0; w < 8; ++w) s += red[(w * 3 + ci) * 128 + j];
            MOD[(size_t)(l * 3 + ci) * NMOD + cgp * 128 + j] = s + a.in[9][(size_t)l * NMOD + cgp * 128 + j]; }
        __syncthreads();
    }
}
__device__ __forceinline__ void p0_transpose_tile(const float* W, int K, int N, bf16_t* WT, int k0, int n0, int rb, LAS float* scr, int lane) {
    const int kk0 = lane >> 4, c4 = (lane & 15) * 4;
    f32x4 v[16];
#pragma unroll
    for (int i = 0; i < 16; ++i) v[i] = *(const f32x4*)(W + (size_t)(k0 + 4 * i + kk0) * N + n0 + c4);
#pragma unroll
    for (int i = 0; i < 16; ++i) { LAS float* d = scr + (4 * i + kk0) * 65 + c4; d[0] = v[i].x; d[1] = v[i].y; d[2] = v[i].z; d[3] = v[i].w; }
    LDS_WAIT();
    const int c = lane & 7;
#pragma unroll
    for (int j = 0; j < 8; ++j) { const int n = (lane >> 3) + 8 * j; const LAS float* s = scr + (8 * c) * 65 + n;
        u32x4 o; o.x = pk_bf16(s[0 * 65], s[1 * 65]); o.y = pk_bf16(s[2 * 65], s[3 * 65]); o.z = pk_bf16(s[4 * 65], s[5 * 65]); o.w = pk_bf16(s[6 * 65], s[7 * 65]);
        *(u32x4*)(WT + (size_t)(rb + n) * K + k0 + 8 * c) = o; }
    LDS_WAIT();
}
__device__ __forceinline__ void p0_convert(const Args& a, LAS unsigned char* lds, int G) {
    const int tid = fresh_tid(), lane = tid & 63, wave = tid >> 6;
    LAS float* scr = (LAS float*)lds + wave * (64 * 65);
    const int gw = blockIdx.x * NWAVES + wave, NGW = G * NWAVES;
    constexpr int I_IN = 32 * 172, I_OUT = 86 * 32, I_QA = 32 * 48, I_QB = 32 * 96, I_O = 32 * 32;
    constexpr int NITEMS = 4 * I_IN + 4 * I_OUT + I_QA + I_QB + 2 * I_O;
    for (int it = gw; it < NITEMS; it += NGW) {
        int r = it;
        if (r < 4 * I_IN) { const int w = r / I_IN; r -= w * I_IN; const int kb = r / 172, nb = r % 172, n0 = nb * 64;
            const int f = n0 < DFF ? n0 : n0 - DFF; const int rb = 256 * (f >> 7) + (f & 127) + (n0 < DFF ? 0 : 128);
            p0_transpose_tile(a.in[12] + (size_t)w * DM * 2 * DFF, DM, 2 * DFF, (bf16_t*)(a.ws + WS_WIN + w * SZ_WIN), kb * 64, n0, rb, scr, lane); continue; }
        r -= 4 * I_IN;
        if (r < 4 * I_OUT) { const int w = r / I_OUT; r -= w * I_OUT; const int kb = r / 32, nb = r % 32;
            p0_transpose_tile(a.in[13] + (size_t)w * DFF * DM, DFF, DM, (bf16_t*)(a.ws + WS_WOUT + w * SZ_WOUT), kb * 64, nb * 64, nb * 64, scr, lane); continue; }
        r -= 4 * I_OUT;
        if (r < I_QA) { const int kb = r / 48, nb = r % 48; p0_transpose_tile(a.in[14], DM, NQKV_A, (bf16_t*)(a.ws + WS_WQA), kb * 64, nb * 64, nb * 64, scr, lane); continue; }
        r -= I_QA;
        if (r < I_QB) { const int kb = r / 96, nb = r % 96; p0_transpose_tile(a.in[18], DM, NQKV_B, (bf16_t*)(a.ws + WS_WQB), kb * 64, nb * 64, nb * 64, scr, lane); continue; }
        r -= I_QB;
        if (r < I_O) { const int kb = r / 32, nb = r % 32; p0_transpose_tile(a.in[17], DM, DM, (bf16_t*)(a.ws + WS_WOA), kb * 64, nb * 64, nb * 64, scr, lane); continue; }
        r -= I_O;
        { const int kb = r / 32, nb = r % 32; p0_transpose_tile(a.in[21], DM, DM, (bf16_t*)(a.ws + WS_WOB), kb * 64, nb * 64, nb * 64, scr, lane); }
    }
    const size_t gt = (size_t)blockIdx.x * NTHREADS + tid, NGT = (size_t)G * NTHREADS;
    constexpr size_t NA8 = (size_t)2 * 256 * 512 / 8, NB8 = (size_t)2 * 256 * 2048 / 8;
    for (size_t i = gt; i < 2 * NA8 + 2 * NB8; i += NGT) {
        const float* src; bf16_t* dst; size_t j; int wdt;
        if (i < NA8) { j = i; src = a.in[2]; dst = (bf16_t*)(a.ws + WS_KA); wdt = 512; }
        else if (i < 2 * NA8) { j = i - NA8; src = a.in[3]; dst = (bf16_t*)(a.ws + WS_VA); wdt = 512; }
        else if (i < 2 * NA8 + NB8) { j = i - 2 * NA8; src = a.in[4]; dst = (bf16_t*)(a.ws + WS_KB); wdt = 2048; }
        else { j = i - 2 * NA8 - NB8; src = a.in[5]; dst = (bf16_t*)(a.ws + WS_VB); wdt = 2048; }
        const size_t e = j * 8, row = e / wdt, col = e % wdt, b = row >> 8, t = row & 255;
        const f32x4 x0 = *(const f32x4*)(src + e), x1 = *(const f32x4*)(src + e + 4);
        u32x4 o; o.x = pk_bf16(x0.x, x0.y); o.y = pk_bf16(x0.z, x0.w); o.z = pk_bf16(x1.x, x1.y); o.w = pk_bf16(x1.z, x1.w);
        *(u32x4*)(dst + (size_t)(4096 + b * 2304 + t) * wdt + col) = o;
    }
}

__device__ __forceinline__ int cidx_of(int row) { return row < NCTX ? 0 : 1 + ((row - NCTX) >> 11); }
__device__ __forceinline__ void ln_phase(const Args& a, bool first, const float* g, const float* bta, const float* modp, int G) {
    const int tid = fresh_tid(), lane = tid & 63, wave = tid >> 6;
    const int gw = blockIdx.x * NWAVES + wave, NGW = G * NWAVES;
    float* X = a.out + OUT_X; bf16_t* H = (bf16_t*)(a.ws + WS_H);
    for (int row = gw; row < MTOK; row += NGW) {
        const float* src = first ? (row < NCTX ? a.in[0] + (size_t)row * DM : a.in[1] + (size_t)(row - NCTX) * DM) : X + (size_t)row * DM;
        f32x4 v[8];
#pragma unroll
        for (int j = 0; j < 8; ++j) v[j] = *(const f32x4*)(src + 4 * lane + 256 * j);
        if (!first) {
            float s = 0.f;
#pragma unroll
            for (int j = 0; j < 8; ++j) s += (v[j].x + v[j].y) + (v[j].z + v[j].w);
            const float mean = wave_sum(s) * (1.f / DM); float s2 = 0.f;
#pragma unroll
            for (int j = 0; j < 8; ++j) { v[j] = v[j] - mean; s2 += (v[j].x * v[j].x + v[j].y * v[j].y) + (v[j].z * v[j].z + v[j].w * v[j].w); }
            const float rstd = 1.0f / sqrtf(wave_sum(s2) * (1.f / DM) + LN_EPS);
#pragma unroll
            for (int j = 0; j < 8; ++j) { const f32x4 gg = *(const f32x4*)(g + 4 * lane + 256 * j), bb = *(const f32x4*)(bta + 4 * lane + 256 * j); v[j] = v[j] * rstd * gg + bb; }
        }
#pragma unroll
        for (int j = 0; j < 8; ++j) *(f32x4*)(X + (size_t)row * DM + 4 * lane + 256 * j) = v[j];
        if (modp) {
            const float* mp = modp + (size_t)cidx_of(row) * NMOD;
#pragma unroll
            for (int j = 0; j < 8; ++j) { const f32x4 sh = *(const f32x4*)(mp + 4 * lane + 256 * j), scl = *(const f32x4*)(mp + DM + 4 * lane + 256 * j);
                const f32x4 h = v[j] * (scl + 1.0f) + sh; u32x2 o; o.x = pk_bf16(h.x, h.y); o.y = pk_bf16(h.z, h.w);
                *(u32x2*)(H + (size_t)row * DM + 4 * lane + 256 * j) = o; }
        }
    }
}
__device__ __forceinline__ void normrope_a(const Args& a, int G) {
    const int tid = fresh_tid(), lane = tid & 63, wave = tid >> 6;
    const int gw = blockIdx.x * NWAVES + wave, NGW = G * NWAVES;
    bf16_t* QKV = (bf16_t*)(a.ws + WS_QKV); bf16_t* KA = (bf16_t*)(a.ws + WS_KA); bf16_t* VA = (bf16_t*)(a.ws + WS_VA);
    const float qn0 = a.in[15][lane], qn1 = a.in[15][64 + lane], kn0 = a.in[16][lane], kn1 = a.in[16][64 + lane];
    const float inv = __builtin_amdgcn_exp2f(-13.287712379549449f * (float)(lane & 31) * (1.0f / 32.0f));
    for (int row = gw; row < MTOK; row += NGW) {
        const bool lat = row >= NCTX; const int s = (row - NCTX) & 2047, b = (row - NCTX) >> 11;
        float cs = 1.f, sn = 0.f;
        if (lat) { const float pos = (float)(lane < 32 ? (s >> 6) : (s & 63)); const float ang = pos * inv; cs = __cosf(ang); sn = __sinf(ang); }
        const int kvrow = lat ? 4096 + b * 2304 + 256 + s : row;
        bf16_t* src = QKV + (size_t)row * NQKV_A;
#pragma unroll 4
        for (int j = 0; j < 20; ++j) {
            const float x1 = bf2f(src[j * 128 + lane]), x2 = bf2f(src[j * 128 + 64 + lane]);
            const float rstd = 1.0f / sqrtf(wave_sum(x1 * x1 + x2 * x2) * (1.f / 128.f) + LN_EPS);
            const float y1 = x1 * rstd * (j < 16 ? qn0 : kn0), y2 = x2 * rstd * (j < 16 ? qn1 : kn1);
            const float o1 = y1 * cs - y2 * sn, o2 = y2 * cs + y1 * sn;
            if (j < 16) { src[j * 128 + lane] = f2bf(o1); src[j * 128 + 64 + lane] = f2bf(o2); }
            else { bf16_t* kd = KA + (size_t)kvrow * 512 + (j - 16) * 128; kd[lane] = f2bf(o1); kd[64 + lane] = f2bf(o2);
                if (!lat) { float* od = a.out + OUT_NAK + (size_t)row * 512 + (j - 16) * 128; od[lane] = o1; od[64 + lane] = o2; } }
        }
        const u32x4 vv = *(const u32x4*)(src + 2560 + lane * 8);
        *(u32x4*)(VA + (size_t)kvrow * 512 + lane * 8) = vv;
        if (!lat) { float* od = a.out + OUT_NAV + (size_t)row * 512 + lane * 8;
            f32x4 lo = {__uint_as_float(vv.x << 16), __uint_as_float(vv.x & 0xffff0000u), __uint_as_float(vv.y << 16), __uint_as_float(vv.y & 0xffff0000u)};
            f32x4 hi = {__uint_as_float(vv.z << 16), __uint_as_float(vv.z & 0xffff0000u), __uint_as_float(vv.w << 16), __uint_as_float(vv.w & 0xffff0000u)};
            *(f32x4*)od = lo; *(f32x4*)(od + 4) = hi; }
    }
}
__device__ __forceinline__ void normrope_b(const Args& a, int G) {
    const int tid = fresh_tid(), lane = tid & 63, wave = tid >> 6;
    const int gw = blockIdx.x * NWAVES + wave, NGW = G * NWAVES;
    bf16_t* QKV = (bf16_t*)(a.ws + WS_QKV); bf16_t* KB = (bf16_t*)(a.ws + WS_KB); bf16_t* VB = (bf16_t*)(a.ws + WS_VB);
    const int i32 = lane & 31, vsel = lane >> 5;
    const float inv = __builtin_amdgcn_exp2f(-13.287712379549449f * (float)(i32 & 15) * (1.0f / 16.0f));
    for (int row = gw; row < MTOK; row += NGW) {
        const bool lat = row >= NCTX; const int s = (row - NCTX) & 2047, b = (row - NCTX) >> 11;
        const int kvrow = lat ? 4096 + b * 2304 + 256 + s : row;
        bf16_t* src = QKV + (size_t)row * NQKV_B;
        if (lat) {
            const float pos = (float)(i32 < 16 ? (s >> 6) : (s & 63)); const float ang = pos * inv; const float cs = __cosf(ang), sn = __sinf(ang);
#pragma unroll 4
            for (int it = 0; it < 32; ++it) {
                const int vec = 2 * it + vsel; bf16_t* p = src + vec * 64;
                const float x1 = bf2f(p[i32]), x2 = bf2f(p[32 + i32]);
                const float o1 = x1 * cs - x2 * sn, o2 = x2 * cs + x1 * sn;
                bf16_t* d = vec < 32 ? p : KB + (size_t)kvrow * 2048 + (vec - 32) * 64;
                d[i32] = f2bf(o1); d[32 + i32] = f2bf(o2);
            }
#pragma unroll
            for (int j = 0; j < 4; ++j) *(u32x4*)(VB + (size_t)kvrow * 2048 + j * 512 + lane * 8) = *(const u32x4*)(src + 4096 + j * 512 + lane * 8);
        } else {
#pragma unroll
            for (int j = 0; j < 8; ++j) {
                const u32x4 vv = *(const u32x4*)(src + 2048 + j * 512 + lane * 8);
                bf16_t* dst = (j < 4 ? KB : VB) + (size_t)kvrow * 2048 + (j & 3) * 512 + lane * 8;
                *(u32x4*)dst = vv;
                float* od = a.out + (j < 4 ? OUT_NBK : OUT_NBV) + (size_t)row * 2048 + (j & 3) * 512 + lane * 8;
                f32x4 lo = {__uint_as_float(vv.x << 16), __uint_as_float(vv.x & 0xffff0000u), __uint_as_float(vv.y << 16), __uint_as_float(vv.y & 0xffff0000u)};
                f32x4 hi = {__uint_as_float(vv.z << 16), __uint_as_float(vv.z & 0xffff0000u), __uint_as_float(vv.w << 16), __uint_as_float(vv.w & 0xffff0000u)};
                *(f32x4*)od = lo; *(f32x4*)(od + 4) = hi;
            }
        }
    }
}
__device__ __forceinline__ void combine_b(const Args& a, int G) {
    const int tid = fresh_tid(), lane = tid & 63, wave = tid >> 6;
    const int gw = blockIdx.x * NWAVES + wave, NGW = G * NWAVES;
    const float* lp = a.in[19];
    const float lam = __expf(wave_sum(lp[lane] * lp[64 + lane])) - __expf(wave_sum(lp[128 + lane] * lp[192 + lane])) + LAM_INIT;
    const float g0 = a.in[20][lane] * (1.0f - LAM_INIT), g1 = a.in[20][64 + lane] * (1.0f - LAM_INIT);
    const float* OT = (const float*)(a.ws + WS_OT); bf16_t* O = (bf16_t*)(a.ws + WS_O);
    for (int row = gw; row < MTOK; row += NGW) {
#pragma unroll 4
        for (int h = 0; h < 16; ++h) {
            const float* p1 = OT + (size_t)row * 4096 + (2 * h) * 128; const float* p2 = p1 + 128;
            const float oa = p1[lane] - lam * p2[lane], ob = p1[64 + lane] - lam * p2[64 + lane];
            const float rstd = 1.0f / sqrtf(wave_sum(oa * oa + ob * ob) * (1.f / 128.f) + LN_EPS);
            O[(size_t)row * DM + h * 128 + lane] = f2bf(oa * rstd * g0); O[(size_t)row * DM + h * 128 + 64 + lane] = f2bf(ob * rstd * g1);
        }
    }
}
__device__ __forceinline__ void attn_a(const Args& a, char* lds, int vcu, int G) {
    const att::bf16* QKV = (const att::bf16*)(a.ws + WS_QKV); const att::bf16* KA = (const att::bf16*)(a.ws + WS_KA); const att::bf16* VA = (const att::bf16*)(a.ws + WS_VA);
    att::bf16* O = (att::bf16*)(a.ws + WS_O);
    for (int u = vcu; u < 512; u += G) {
        if (u < 256) { const int b = u >> 7, h = (u >> 3) & 15, qt = u & 7; const size_t qrow = 4096 + (size_t)b * 2048 + qt * 256, krow = 4096 + (size_t)b * 2304;
            att::attn_dense_body<128, att::bf16>(QKV + qrow * NQKV_A + h * 128, NQKV_A, KA + krow * 512 + (h >> 2) * 128, 512, VA + krow * 512 + (h >> 2) * 128, 512, O + qrow * DM + h * 128, DM, 2304, lds); }
        else { const int v = u - 256, b = v >> 4, h = v & 15; const size_t qrow = (size_t)b * 256;
            att::attn_dense_body<128, att::bf16>(QKV + qrow * NQKV_A + h * 128, NQKV_A, KA + qrow * 512 + (h >> 2) * 128, 512, VA + qrow * 512 + (h >> 2) * 128, 512, O + qrow * DM + h * 128, DM, 256, lds); }
    }
}
__device__ __forceinline__ void attn_b(const Args& a, char* lds, int vcu, int G) {
    const att::bf16* QKV = (const att::bf16*)(a.ws + WS_QKV); const att::bf16* KB = (const att::bf16*)(a.ws + WS_KB); const att::bf16* VB = (const att::bf16*)(a.ws + WS_VB);
    float* OT = (float*)(a.ws + WS_OT);
    for (int u = vcu; u < 1024; u += G) {
        if (u < 512) { const int b = u >> 8, hp = (u >> 3) & 31, qt = u & 7; const size_t qrow = 4096 + (size_t)b * 2048 + qt * 256, krow = 4096 + (size_t)b * 2304;
            att::attn_dense_body<64, float>(QKV + qrow * NQKV_B + hp * 64, NQKV_B, KB + krow * 2048 + hp * 64, 2048, VB + krow * 2048 + (hp >> 1) * 128, 2048, OT + qrow * 4096 + hp * 128, 4096, 2304, lds); }
        else { const int v = u - 512, b = v >> 5, hp = v & 31; const size_t qrow = (size_t)b * 256;
            att::attn_dense_body<64, float>(QKV + qrow * NQKV_B + hp * 64, NQKV_B, KB + qrow * 2048 + hp * 64, 2048, VB + qrow * 2048 + (hp >> 1) * 128, 2048, OT + qrow * 4096 + hp * 128, 4096, 256, lds); }
    }
}

__global__ void __launch_bounds__(NTHREADS, 2) mega_fwd(Args a) {
    extern __shared__ __attribute__((aligned(16))) unsigned char lds_raw[];
    LAS unsigned char* lds = (LAS unsigned char*)lds_raw;
    cg::grid_group grid = cg::this_grid();
    const int G = gridDim.x, bx = blockIdx.x;
    const int vcu = (G % 8 == 0) ? (bx % 8) * (G / 8) + bx / 8 : bx;
    const float* MOD = (const float*)(a.ws + WS_MOD);
    volatile LAS unsigned* misc = (volatile LAS unsigned*)(lds + LDS_BYTES - 64);
    if (threadIdx.x < 16) misc[threadIdx.x] = 0u;
    __syncthreads();
    const XcdBarrier bar = xcd_barrier_post((unsigned*)(a.ws + WS_BAR), misc);
    if (a.ph_hi < 0) grid.sync();
    int ph = 0;
#define RUNN(n, ...) do { if (ph >= a.ph_lo && ph < a.ph_hi) { for (int rep_ = 0; rep_ < (n); ++rep_) { const bool PROBE_DRY = rep_ + 1 < (n); (void)PROBE_DRY; __VA_ARGS__; \
        if (ph + 1 < a.ph_hi) { xcd_barrier(bar); if (PROBE & 2) xcd_barrier(bar); } } } ++ph; } while (0)
#define RUN(...) RUNN(1, __VA_ARGS__)

    RUNN((PROBE & 1) ? 2 : 1, { p0_gemv(a, lds, G); p0_convert(a, lds, G); });
    RUN(ln_phase(a, true, nullptr, nullptr, MOD, G));
    for (int l = 0; l < 2; ++l) {
        for (int s = 0; s < 3; ++s) {
            const float* modl = MOD + (size_t)l * 3 * NMOD;
            if (s != 1) {
                const int w = l * 2 + (s >> 1);
                RUNN((PROBE & 4) ? 2 : 1, { pg8::Gemm g{(const bf16_t*)(a.ws + WS_H), (const bf16_t*)(a.ws + WS_WIN + w * SZ_WIN), MTOK, 2 * DFF, DM};
                      pg8::StaticOrder S; S.init(MTOK, 2 * DFF, G, bx);
                      pg8::EpiSwiglu E{(bf16_t*)(a.ws + WS_ACT), DFF};
                      pg8::gemm_phase<pg8::EpiSwiglu, pg8::StaticOrder, true, true>(lds, g, S, E); });
                RUNN((PROBE & 16) ? 2 : 1, { pg8::Gemm g{(const bf16_t*)(a.ws + WS_ACT), (const bf16_t*)(a.ws + WS_WOUT + w * SZ_WOUT), MTOK, DM, DFF};
                      pg8::StaticOrder S; S.init(MTOK, DM, G, bx);
                      pg8::EpiRes E{a.out + OUT_X, PROBE_DRY ? (float*)(a.ws + WS_OT) : a.out + OUT_X, modl + s * 3 * DM + 2 * DM, NMOD, ALPHA, 0.5f};
                      pg8::gemm_phase<pg8::EpiRes, pg8::StaticOrder, true, true>(lds, g, S, E); });
            } else {
                const int nq = l == 0 ? NQKV_A : NQKV_B;
                RUNN((PROBE & 32) ? 2 : 1, { pg8::Gemm g{(const bf16_t*)(a.ws + WS_H), (const bf16_t*)(a.ws + (l == 0 ? WS_WQA : WS_WQB)), MTOK, nq, DM};
                      pg8::StaticOrder S; S.init(MTOK, nq, G, bx);
                      pg8::EpiPlain E{(bf16_t*)(a.ws + WS_QKV), nq};
                      pg8::gemm_phase<pg8::EpiPlain, pg8::StaticOrder, true, true>(lds, g, S, E); });
                if (l == 0) {
                    RUN(normrope_a(a, G));
                    RUNN((PROBE & 8) ? 2 : 1, attn_a(a, (char*)lds_raw, vcu, G));
                } else {
                    RUN(normrope_b(a, G));
                    RUNN((PROBE & 8) ? 2 : 1, attn_b(a, (char*)lds_raw, vcu, G));
                    RUN(combine_b(a, G));
                }
                RUN({ pg8::Gemm g{(const bf16_t*)(a.ws + WS_O), (const bf16_t*)(a.ws + (l == 0 ? WS_WOA : WS_WOB)), MTOK, DM, DM};
                      pg8::StaticOrder S; S.init(MTOK, DM, G, bx);
                      pg8::EpiRes E{a.out + OUT_X, a.out + OUT_X, modl + s * 3 * DM + 2 * DM, NMOD, ALPHA, 1.0f};
                      pg8::gemm_phase<pg8::EpiRes, pg8::StaticOrder, true, true>(lds, g, S, E); });
            }
            const float* nmod = s < 2 ? modl + (s + 1) * 3 * DM : (l == 0 ? MOD + (size_t)3 * NMOD : nullptr);
            RUN(ln_phase(a, false, a.in[10] + (size_t)(l * 3 + s) * DM, a.in[11] + (size_t)(l * 3 + s) * DM, nmod, G));
        }
    }
#undef RUN
#undef RUNN
}
constexpr int N_PHASES = 2 + 3 + 3 + 4 + 3 + 3 + 5 + 3 + 1;

#ifndef MK_MULTI
#define MK_MULTI 0
#endif
extern "C" void kernel_launch(void* const* d_in, const int* in_sizes, int n_in, void* d_out, int out_size, void* d_ws, size_t ws_size, hipStream_t stream) {
    static int grid = 0;
    if (grid == 0) {
        if (n_in != 22 || ws_size < WS_END || out_size != (int)(OUT_NBV + (size_t)NCTX * 2048)) { fprintf(stderr, "kernel_launch: unexpected shapes (n_in %d, out %d, ws %zu need %zu)\n", n_in, out_size, ws_size, (size_t)WS_END); grid = -1; return; }
        int dev = 0, cus = 0, per_cu = 0;
        hipGetDevice(&dev); hipDeviceGetAttribute(&cus, hipDeviceAttributeMultiprocessorCount, dev);
        if (hipFuncSetAttribute((const void*)mega_fwd, hipFuncAttributeMaxDynamicSharedMemorySize, LDS_BYTES) != hipSuccess) { fprintf(stderr, "kernel_launch: hipFuncSetAttribute failed\n"); grid = -1; return; }
        if (hipOccupancyMaxActiveBlocksPerMultiprocessor(&per_cu, (const void*)mega_fwd, NTHREADS, LDS_BYTES) != hipSuccess || per_cu < 1) { fprintf(stderr, "kernel_launch: occupancy query gives %d\n", per_cu); per_cu = 1; }
        (void)hipGetLastError();
        grid = cus * 1;
    }
    if (grid < 0) return;
    if (hipMemsetAsync((char*)d_ws + WS_BAR, 0, BAR_BYTES, stream) != hipSuccess) { fprintf(stderr, "kernel_launch: memset failed\n"); return; }
    Args a{};
    for (int i = 0; i < 22; ++i) a.in[i] = (const float*)d_in[i];
    a.out = (float*)d_out; a.ws = (unsigned char*)d_ws;
#if MK_MULTI
    for (int p = 0; p < 25; ++p) { a.ph_lo = p; a.ph_hi = p + 1; hipLaunchKernelGGL(mega_fwd, dim3(grid), dim3(NTHREADS), LDS_BYTES, stream, a); }
#else
    a.ph_lo = 0; a.ph_hi = 1000;
    void* args[] = {&a};
    hipError_t e = hipLaunchCooperativeKernel((const void*)mega_fwd, dim3(grid), dim3(NTHREADS), args, LDS_BYTES, stream);
    if (e != hipSuccess) fprintf(stderr, "kernel_launch: cooperative launch failed: %s (grid %d)\n", hipGetErrorString(e), grid);
#endif
}
```

```cpp
#include <hip/hip_runtime.h>
#include <hip/hip_bf16.h>
#include <hip/hip_cooperative_groups.h>
#include <cstdio>
#include <cstdint>
__device__ __forceinline__ int fresh_tid() { int t = threadIdx.x; asm volatile("" : "+v"(t)); return t; }
namespace pg8 {
#define PG8_LAS __attribute__((address_space(3)))
typedef unsigned short bf16_t;
typedef short bf16x8 __attribute__((ext_vector_type(8)));
typedef float f32x4 __attribute__((ext_vector_type(4)));
typedef unsigned u32x4 __attribute__((ext_vector_type(4)));
constexpr int BM = 256, BK = 64, HALF = 128, HTB = HALF * BK * 2  , STAGE_BYTES = 8 * HTB, NXCD = 8, WGM = 8;

__host__ __device__ __forceinline__ int lds_byte(int r, int c) { const int st = (r >> 4) * 2 + (c >> 5), rr = r & 15, cc = c & 31, ob = rr * 64 + cc * 2; return st * 1024 + (ob ^ (((ob >> 9) & 1) << 5)); }
__host__ __device__ __forceinline__ void stage_rc(int b, int& R, int& C) { const int st = b / 1024, sb = b % 1024, swz = sb ^ (((sb >> 9) & 1) << 5); R = (st >> 1) * 16 + swz / 64; C = (st & 1) * 32 + (swz % 64) / 2; }
__host__ __device__ __forceinline__ int perm32(int rho) { const int n = rho >> 4, i = rho & 15; return 8 * (i >> 2) + 4 * n + (i & 3); }

struct Unit { int pm, pn; };
struct Gemm { const bf16_t* A; const bf16_t* Bt; int M, N, K; };

struct StaticOrder {
    int nM, nN, nwg, G, c;
    __host__ __device__ void init(int M, int N, int G_, int c_) { nM = M / BM; nN = N / BM; nwg = nM * nN; G = G_; c = c_; }
    __host__ __device__ bool next(int i, Unit& u) const {
        const long L = (long)i * G + c; if (L >= nwg) return false;
        int wgid = (int)L; { const int q = nwg / NXCD, r = nwg % NXCD, xcd = wgid % NXCD, off = wgid / NXCD; wgid = (xcd < r ? xcd * (q + 1) : r * (q + 1) + (xcd - r) * q) + off; }
        const int nig = WGM * nN, gid = wgid / nig, fm = gid * WGM, gsz = (nM - fm) < WGM ? (nM - fm) : WGM;
        u.pm = fm + ((wgid % nig) % gsz); u.pn = (wgid % nig) / gsz; return true;
    }
    __device__ __forceinline__ void a_ready(const Unit&) const {}
    __device__ __forceinline__ void done(const Unit&) const {}
};

__device__ __forceinline__ unsigned cvt_pk_bf16(float lo, float hi) { unsigned r; asm volatile("v_cvt_pk_bf16_f32 %0, %1, %2" : "=v"(r) : "v"(lo), "v"(hi)); return r; }
typedef float f32x2 __attribute__((ext_vector_type(2)));
__device__ __forceinline__ float silu_f(float g) { return g * __builtin_amdgcn_rcpf(1.0f + __builtin_amdgcn_exp2f(-1.4426950408889634f * g)); }
struct EpiSwiglu {
    static constexpr bool PERM = true, AFTER_DRAIN = false;
    bf16_t* O; int ldc;
    __device__ __forceinline__ void operator()(const f32x4 (&acc)[2][2][4][2], const Unit& u, int wr, int wc, int fr, int fq) const {
        const int row0 = u.pm * BM + wr * 64 + fr, col0 = u.pn * HALF + wc * 32 + 8 * fq;
#pragma unroll
        for (int ai = 0; ai < 2; ++ai)
#pragma unroll
            for (int m = 0; m < 4; ++m) {
                bf16_t* rowp = O + (size_t)(row0 + ai * HALF + m * 16) * ldc + col0;
                const f32x4 g0 = acc[ai][0][m][0], g1 = acc[ai][0][m][1], u0 = acc[ai][1][m][0], u1 = acc[ai][1][m][1];
                u32x4 w;
                w.x = cvt_pk_bf16(silu_f(g0[0]) * u0[0], silu_f(g0[1]) * u0[1]); w.y = cvt_pk_bf16(silu_f(g0[2]) * u0[2], silu_f(g0[3]) * u0[3]);
                w.z = cvt_pk_bf16(silu_f(g1[0]) * u1[0], silu_f(g1[1]) * u1[1]); w.w = cvt_pk_bf16(silu_f(g1[2]) * u1[2], silu_f(g1[3]) * u1[3]);
                *(u32x4*)rowp = w;
            }
    }
};
struct EpiPlain {
    static constexpr bool PERM = true, AFTER_DRAIN = false;
    bf16_t* O; int ldc;
    __device__ __forceinline__ void operator()(const f32x4 (&acc)[2][2][4][2], const Unit& u, int wr, int wc, int fr, int fq) const {
        const int row0 = u.pm * BM + wr * 64 + fr, col0 = u.pn * BM + wc * 32 + 8 * fq;
#pragma unroll
        for (int ai = 0; ai < 2; ++ai)
#pragma unroll
            for (int m = 0; m < 4; ++m) {
                bf16_t* rowp = O + (size_t)(row0 + ai * HALF + m * 16) * ldc + col0;
#pragma unroll
                for (int bj = 0; bj < 2; ++bj) {
                    const f32x4 v0 = acc[ai][bj][m][0], v1 = acc[ai][bj][m][1];
                    u32x4 w; w.x = cvt_pk_bf16(v0[0], v0[1]); w.y = cvt_pk_bf16(v0[2], v0[3]); w.z = cvt_pk_bf16(v1[0], v1[1]); w.w = cvt_pk_bf16(v1[2], v1[3]);
                    *(u32x4*)(rowp + bj * HALF) = w;
                }
            }
    }
};
struct EpiRes {
    static constexpr bool PERM = false, AFTER_DRAIN = false;
    const float* X; float* Xo; const float* gate;   int gate_stride; float alpha, gs;
    __device__ __forceinline__ void operator()(const f32x4 (&acc)[2][2][4][2], const Unit& u, int wr, int wc, int fr, int fq) const {
        const int cidx = u.pm < 16 ? 0 : (u.pm < 24 ? 1 : 2);
        const int row0 = u.pm * BM + wr * 64 + fr, col0 = u.pn * BM + wc * 32 + 4 * fq;
        const float* gp = gate + (size_t)cidx * gate_stride + col0;
        f32x4 gv[2][2];
#pragma unroll
        for (int bj = 0; bj < 2; ++bj)
#pragma unroll
            for (int n = 0; n < 2; ++n) gv[bj][n] = *(const f32x4*)(gp + bj * HALF + n * 16) * gs;
#pragma unroll
        for (int ai = 0; ai < 2; ++ai)
#pragma unroll
            for (int m = 0; m < 4; ++m) {
                const size_t ro = (size_t)(row0 + ai * HALF + m * 16) * 2048 + col0; const float* rowp = X + ro; float* rowo = Xo + ro;
#pragma unroll
                for (int bj = 0; bj < 2; ++bj)
#pragma unroll
                    for (int n = 0; n < 2; ++n) {
                        const f32x4 x = *(const f32x4*)(rowp + bj * HALF + n * 16);
                        *(f32x4*)(rowo + bj * HALF + n * 16) = x * alpha + gv[bj][n] * acc[ai][bj][m][n];
                    }
                if (m & 1) asm volatile("" ::: "memory");
            }
    }
};
template <class Epi, class Sched, bool ALIGN_EPI = false, bool SP2 = false>
__device__ __forceinline__ void gemm_phase(PG8_LAS unsigned char* lds, const Gemm g, const Sched& S, const Epi& E) {
    const int tid = fresh_tid(), wid = __builtin_amdgcn_readfirstlane(tid >> 6), lane = tid & 63, wr = wid >> 2, wc = wid & 3, fr = lane & 15, fq = lane >> 4;
    const int K = g.K, nt = K / BK;
    unsigned voffA[2], voffB[2];
#pragma unroll
    for (int i = 0; i < 2; ++i) { int R, C; stage_rc(tid * 16 + i * 8192, R, C); const int Rb = Epi::PERM ? ((R & ~31) + perm32(R & 31)) : R;
        voffA[i] = (unsigned)(R * K + C) * 2u; voffB[i] = (unsigned)(Rb * K + C) * 2u; }
    const size_t kstep = (size_t)(BK * 2);
    const size_t hstep = (size_t)HALF * K * 2;
    const size_t tstep = 2 * hstep;
    const unsigned ldsw = (unsigned)wid * 1024u;
    const int aoff = lds_byte(wr * 64 + fr, fq * 8), boff = lds_byte(wc * 32 + fr, fq * 8);
#define PG8_SA(b, h) (((b) * 2 + (h)) * HTB)
#define PG8_SB(b, h) ((4 + (b) * 2 + (h)) * HTB)
#define PG8_STAGE(bufoff, gbase, voff) do { _Pragma("unroll") for (int _i = 0; _i < 2; ++_i) \
        __builtin_amdgcn_global_load_lds((const unsigned*)((const char*)(gbase) + (voff)[_i]), (PG8_LAS unsigned*)(lds + (bufoff) + ldsw + _i * 8192), 16, 0, 0); } while (0)
#define PG8_LDA(dst, b, h) do { _Pragma("unroll") for (int m = 0; m < 4; ++m) _Pragma("unroll") for (int k = 0; k < 2; ++k) dst[m][k] = *(const PG8_LAS bf16x8*)(lds + PG8_SA(b, h) + aoff + m * 2048 + k * 1024); } while (0)
#define PG8_LDB(dst, b, h) do { _Pragma("unroll") for (int n = 0; n < 2; ++n) _Pragma("unroll") for (int k = 0; k < 2; ++k) dst[n][k] = *(const PG8_LAS bf16x8*)(lds + PG8_SB(b, h) + boff + n * 2048 + k * 1024); } while (0)
#define PG8_MMA(ai, bj, At, Bt) do { __builtin_amdgcn_s_setprio(1); _Pragma("unroll") for (int m = 0; m < 4; ++m) _Pragma("unroll") for (int n = 0; n < 2; ++n) _Pragma("unroll") for (int k = 0; k < 2; ++k) \
        acc[ai][bj][m][n] = __builtin_amdgcn_mfma_f32_16x16x32_bf16(Bt[n][k], At[m][k], acc[ai][bj][m][n], 0, 0, 0); __builtin_amdgcn_s_setprio(0); } while (0)
#define PG8_WAIT_V(n) asm volatile("s_waitcnt vmcnt(" #n ")" ::: "memory")
#define PG8_WAIT_L(n) asm volatile("s_waitcnt lgkmcnt(" #n ")" ::: "memory")
#define PG8_BAR __builtin_amdgcn_s_barrier()
#define PG8_SCHED __builtin_amdgcn_sched_barrier(0)
    Unit cur, nxt; int ui = 0;
    if (!S.next(0, cur)) return;
    f32x4 acc[2][2][4][2];
#pragma unroll
    for (int a = 0; a < 2; ++a)
#pragma unroll
        for (int b = 0; b < 2; ++b)
#pragma unroll
            for (int m = 0; m < 4; ++m)
#pragma unroll
                for (int n = 0; n < 2; ++n) acc[a][b][m][n] = (f32x4){0.f, 0.f, 0.f, 0.f};
    bf16x8 At[4][2], B0[2][2], B1[2][2];
    const char* cA = (const char*)g.A + (size_t)cur.pm * tstep; const char* cB = (const char*)g.Bt + (size_t)cur.pn * tstep;
    S.a_ready(cur);
    if constexpr (SP2) {
        PG8_STAGE(PG8_SB(0, 0), cB, voffB); PG8_STAGE(PG8_SB(0, 1), cB + hstep, voffB); PG8_STAGE(PG8_SA(0, 0), cA, voffA); PG8_STAGE(PG8_SA(0, 1), cA + hstep, voffA);
        if (wr == 1) PG8_BAR;
        PG8_WAIT_V(2); PG8_BAR;
        PG8_STAGE(PG8_SB(1, 0), cB + kstep, voffB); PG8_STAGE(PG8_SA(1, 0), cA + kstep, voffA); PG8_STAGE(PG8_SB(1, 1), cB + hstep + kstep, voffB);
        PG8_WAIT_V(6); PG8_BAR;
    } else {
        PG8_STAGE(PG8_SB(0, 0), cB, voffB); PG8_STAGE(PG8_SA(0, 0), cA, voffA); PG8_STAGE(PG8_SB(0, 1), cB + hstep, voffB); PG8_STAGE(PG8_SA(0, 1), cA + hstep, voffA);
        if (wr == 1) PG8_BAR;
        PG8_WAIT_V(4); PG8_BAR;
        PG8_STAGE(PG8_SB(1, 0), cB + kstep, voffB); PG8_STAGE(PG8_SA(1, 0), cA + kstep, voffA); PG8_STAGE(PG8_SB(1, 1), cB + hstep + kstep, voffB);
        PG8_WAIT_V(6); PG8_BAR;
    }
    for (;;) {
        const bool has_next = S.next(ui + 1, nxt);
        const char* nA = has_next ? (const char*)g.A + (size_t)nxt.pm * tstep : cA; const char* nB = has_next ? (const char*)g.Bt + (size_t)nxt.pn * tstep : cB;
        for (int t = 0; t < nt; t += 2) {
            const bool last = (t == nt - 2);
            const char* a1 = cA + (size_t)(t + 1) * kstep;
            const char* a2 = last ? nA : cA + (size_t)(t + 2) * kstep; const char* b2 = last ? nB : cB + (size_t)(t + 2) * kstep;
            const char* a3 = a2 + kstep; const char* b3 = b2 + kstep;
            if (last && has_next) S.a_ready(nxt);
            if constexpr (SP2) {
            PG8_LDB(B0, 0, 0); PG8_LDB(B1, 0, 1); PG8_SCHED; PG8_LDA(At, 0, 0); PG8_STAGE(PG8_SA(1, 1), a1 + hstep, voffA);
            PG8_WAIT_V(8); PG8_WAIT_L(0); PG8_BAR; PG8_MMA(0, 0, At, B0); PG8_MMA(0, 1, At, B1); PG8_BAR; PG8_SCHED;
            PG8_LDA(At, 0, 1); PG8_STAGE(PG8_SB(0, 0), b2, voffB); PG8_STAGE(PG8_SB(0, 1), b2 + hstep, voffB); PG8_STAGE(PG8_SA(0, 0), a2, voffA);
            PG8_WAIT_V(8); PG8_WAIT_L(0); PG8_BAR; PG8_MMA(1, 0, At, B0); PG8_MMA(1, 1, At, B1); PG8_BAR; PG8_SCHED;
            PG8_LDB(B0, 1, 0); PG8_LDB(B1, 1, 1); PG8_SCHED; PG8_LDA(At, 1, 0); PG8_STAGE(PG8_SA(0, 1), a2 + hstep, voffA);
            PG8_WAIT_V(8); PG8_WAIT_L(0); PG8_BAR; PG8_MMA(0, 0, At, B0); PG8_MMA(0, 1, At, B1); PG8_BAR; PG8_SCHED;
            PG8_LDA(At, 1, 1); PG8_STAGE(PG8_SB(1, 0), b3, voffB); PG8_STAGE(PG8_SB(1, 1), b3 + hstep, voffB); PG8_STAGE(PG8_SA(1, 0), a3, voffA);
            PG8_WAIT_V(8); PG8_WAIT_L(0); PG8_BAR; PG8_MMA(1, 0, At, B0); PG8_MMA(1, 1, At, B1); PG8_BAR; PG8_SCHED;
            } else {
            PG8_LDB(B0, 0, 0); PG8_SCHED; PG8_LDA(At, 0, 0); PG8_STAGE(PG8_SA(1, 1), a1 + hstep, voffA);
            PG8_WAIT_L(8); PG8_BAR; PG8_WAIT_L(0); PG8_MMA(0, 0, At, B0); PG8_BAR; PG8_SCHED;
            PG8_LDB(B1, 0, 1); PG8_STAGE(PG8_SB(0, 0), b2, voffB);
            PG8_BAR; PG8_WAIT_L(0); PG8_MMA(0, 1, At, B1); PG8_BAR;
            PG8_LDA(At, 0, 1); PG8_STAGE(PG8_SA(0, 0), a2, voffA);
            PG8_BAR; PG8_WAIT_L(0); PG8_MMA(1, 0, At, B0); PG8_BAR; PG8_SCHED;
            PG8_STAGE(PG8_SB(0, 1), b2 + hstep, voffB);
            PG8_WAIT_V(6); PG8_BAR; PG8_MMA(1, 1, At, B1); PG8_BAR;
            PG8_LDB(B0, 1, 0); PG8_SCHED; PG8_LDA(At, 1, 0); PG8_STAGE(PG8_SA(0, 1), a2 + hstep, voffA);
            PG8_WAIT_L(8); PG8_BAR; PG8_WAIT_L(0); PG8_MMA(0, 0, At, B0); PG8_BAR; PG8_SCHED;
            PG8_LDB(B1, 1, 1); PG8_STAGE(PG8_SB(1, 0), b3, voffB);
            PG8_BAR; PG8_WAIT_L(0); PG8_MMA(0, 1, At, B1); PG8_BAR;
            PG8_LDA(At, 1, 1); PG8_STAGE(PG8_SA(1, 0), a3, voffA);
            PG8_BAR; PG8_WAIT_L(0); PG8_MMA(1, 0, At, B0); PG8_BAR; PG8_SCHED;
            PG8_STAGE(PG8_SB(1, 1), b3 + hstep, voffB);
            PG8_WAIT_V(6); PG8_BAR; PG8_MMA(1, 1, At, B1); PG8_BAR;
            }
        }
        if constexpr (ALIGN_EPI) { if (wr == 0) PG8_BAR; }
        if constexpr (!Epi::AFTER_DRAIN) { E(acc, cur, wr, wc, fr, fq); S.done(cur); }
        if (!has_next) break;
#pragma unroll
        for (int a = 0; a < 2; ++a)
#pragma unroll
            for (int b = 0; b < 2; ++b)
#pragma unroll
                for (int m = 0; m < 4; ++m)
#pragma unroll
                    for (int n = 0; n < 2; ++n) acc[a][b][m][n] = (f32x4){0.f, 0.f, 0.f, 0.f};
        cur = nxt; cA = nA; cB = nB; ++ui;
        if constexpr (ALIGN_EPI) { if (wr == 1) PG8_BAR; }
    }
    PG8_WAIT_V(0);
    if constexpr (!ALIGN_EPI) { if (wr == 0) PG8_BAR; }
    PG8_BAR;
    if constexpr (Epi::AFTER_DRAIN) { E.fused(acc, cur, wr, wc, fr, fq, lds, wid, lane); S.done(cur); }
#undef PG8_SA
#undef PG8_SB
#undef PG8_STAGE
#undef PG8_LDA
#undef PG8_LDB
#undef PG8_MMA
#undef PG8_WAIT_V
#undef PG8_WAIT_L
#undef PG8_BAR
#undef PG8_SCHED
}
}
namespace att {
using bf16 = __hip_bfloat16;
constexpr int DV = 128, NW = 8, QBLK = 32, KVBLK = 64;
constexpr float THR = 8.f;
constexpr size_t SHM_V = KVBLK * DV * 2, SHM_K = KVBLK * 128 * 2, SHM_ATTN = 2 * SHM_V + 2 * SHM_K + NW * 64 * 4;
using bf16x8 = __attribute__((ext_vector_type(8))) short;
using s16x4  = __attribute__((ext_vector_type(4))) short;
using f32x16 = __attribute__((ext_vector_type(16))) float;
using u32x4  = __attribute__((ext_vector_type(4))) unsigned;
#define KSWZ(row, colB) ((row) * 256 + ((colB) ^ (((row) & 7) << 4)))
#define KSWZ64(row, colB) ((row) * 128 + ((colB) ^ (((row) & 7) << 4)))
#define SBAR() __builtin_amdgcn_sched_barrier(0)
template <int DQK> __device__ __forceinline__ constexpr float scale_of() { return DQK == 128 ? 0.088388347648318440f : 0.125f; }
__device__ __forceinline__ int crow(int r, int hi) { return (r & 3) + 8 * (r >> 2) + 4 * hi; }
__device__ __forceinline__ unsigned cvtpk(float lo, float hi) { unsigned r; asm volatile("v_cvt_pk_bf16_f32 %0, %1, %2" : "=v"(r) : "v"(lo), "v"(hi)); return r; }

template <int DQK>
__device__ __forceinline__ void partialSM(f32x16& p0, f32x16& p1, float& m_reg, float& mn, float& alpha) {
  constexpr float SCALE = scale_of<DQK>();
  constexpr float C = SCALE * 1.4426950408889634f;
  float pmax = p0[0];
#pragma unroll
  for (int r = 1; r < 16; ++r) pmax = fmaxf(pmax, p0[r]);
#pragma unroll
  for (int r = 0; r < 16; ++r) pmax = fmaxf(pmax, p1[r]);
  { auto rr = __builtin_amdgcn_permlane32_swap(__float_as_uint(pmax), __float_as_uint(pmax), false, false);
    pmax = fmaxf(__uint_as_float(rr[0]), __uint_as_float(rr[1])); }
  if (__builtin_expect(__all(pmax - m_reg <= THR / SCALE), 1)) { mn = m_reg; alpha = 1.f; }
  else { mn = fmaxf(m_reg, pmax); alpha = __builtin_amdgcn_exp2f((m_reg - mn) * C); m_reg = mn; }
  float mnC = -mn * C;
#pragma unroll
  for (int r = 0; r < 16; ++r) p0[r] = fmaf(p0[r], C, mnC);
#pragma unroll
  for (int r = 0; r < 16; ++r) p1[r] = fmaf(p1[r], C, mnC);
#pragma unroll
  for (int r = 0; r < 16; ++r) p0[r] = __builtin_amdgcn_exp2f(p0[r]);
}
__device__ __forceinline__ void finishSM(f32x16& p0, f32x16& p1, float alpha, float& l_reg, bf16x8& pa0, bf16x8& pa1, bf16x8& pa2, bf16x8& pa3) {
#pragma unroll
  for (int r = 0; r < 16; ++r) p1[r] = __builtin_amdgcn_exp2f(p1[r]);
  float ps = 0;
#pragma unroll
  for (int r = 0; r < 16; ++r) ps += p0[r];
#pragma unroll
  for (int r = 0; r < 16; ++r) ps += p1[r];
  { auto rr = __builtin_amdgcn_permlane32_swap(__float_as_uint(ps), __float_as_uint(ps), false, false);
    ps = __uint_as_float(rr[0]) + __uint_as_float(rr[1]); }
  l_reg = l_reg * alpha + ps;
#define PK4(P, BASE, OUT) do { unsigned a0 = cvtpk(P[BASE + 0], P[BASE + 1]), a1 = cvtpk(P[BASE + 2], P[BASE + 3]);   \
    unsigned b0 = cvtpk(P[BASE + 4], P[BASE + 5]), b1 = cvtpk(P[BASE + 6], P[BASE + 7]);                              \
    auto r0 = __builtin_amdgcn_permlane32_swap(a0, b0, false, false); auto r1 = __builtin_amdgcn_permlane32_swap(a1, b1, false, false); \
    u32x4 w = {r0[0], r1[0], r0[1], r1[1]}; OUT = *reinterpret_cast<bf16x8*>(&w); } while (0)
  PK4(p0, 0, pa0); PK4(p0, 8, pa1); PK4(p1, 0, pa2); PK4(p1, 8, pa3);
#undef PK4
}
template <int DQK>
__device__ __forceinline__ void qkt(f32x16& p0, f32x16& p1, const bf16* Ks, const bf16x8* qr, int r32, int hi) {
  p0 = f32x16{}; p1 = f32x16{};
#pragma unroll
  for (int d0 = 0; d0 < DQK / 16; ++d0) { int cb = (d0 * 16 + hi * 8) * 2;
    bf16x8 b0, b1;
    if constexpr (DQK == 128) { b0 = *reinterpret_cast<const bf16x8*>((const char*)Ks + KSWZ(r32, cb)); b1 = *reinterpret_cast<const bf16x8*>((const char*)Ks + KSWZ(32 + r32, cb)); }
    else { b0 = *reinterpret_cast<const bf16x8*>((const char*)Ks + KSWZ64(r32, cb)); b1 = *reinterpret_cast<const bf16x8*>((const char*)Ks + KSWZ64(32 + r32, cb)); }
    p0 = __builtin_amdgcn_mfma_f32_32x32x16_bf16(b0, qr[d0], p0, 0, 0, 0);
    p1 = __builtin_amdgcn_mfma_f32_32x32x16_bf16(b1, qr[d0], p1, 0, 0, 0); }
}
__device__ __forceinline__ int v_st(int k, int c) { const int kk = (k & ~0xC) | ((k & 4) << 1) | ((k & 8) >> 1); return ((kk >> 3) * 4 + (c >> 5)) * 512 + ((kk & 7) * 32 + (c & 31)) * 2; }
__device__ __forceinline__ int v_rd_base(int lane) { return ((lane & 3) << 3) | (((lane >> 2) & 3) << 6) | (((lane >> 4) & 1) << 5) | (((lane >> 5) & 1) << 8); }
constexpr int v_rd_off(int d0, int ks, int half) { return d0 * 512 + ks * 4096 + half * 2048; }
template <int OFF> __device__ __forceinline__ s16x4 tr_read(int vb) {
  s16x4 r; asm volatile("ds_read_b64_tr_b16 %0, %1 offset:%2" : "=&v"(r) : "v"(vb), "i"(OFF) : "memory"); return r;
}
template <int D0> __device__ __forceinline__ void pv_one(f32x16& od, int vb, bf16x8 pa0, bf16x8 pa1, bf16x8 pa2, bf16x8 pa3) {
  const s16x4 l0 = tr_read<v_rd_off(D0, 0, 0)>(vb), h0 = tr_read<v_rd_off(D0, 0, 1)>(vb), l1 = tr_read<v_rd_off(D0, 1, 0)>(vb), h1 = tr_read<v_rd_off(D0, 1, 1)>(vb);
  const s16x4 l2 = tr_read<v_rd_off(D0, 2, 0)>(vb), h2 = tr_read<v_rd_off(D0, 2, 1)>(vb), l3 = tr_read<v_rd_off(D0, 3, 0)>(vb), h3 = tr_read<v_rd_off(D0, 3, 1)>(vb);
  asm volatile("s_waitcnt lgkmcnt(0)" ::: "memory"); SBAR();
#define PK(L, H) (bf16x8){L[0], L[1], L[2], L[3], H[0], H[1], H[2], H[3]}
  od = __builtin_amdgcn_mfma_f32_32x32x16_bf16(pa0, PK(l0, h0), od, 0, 0, 0);
  od = __builtin_amdgcn_mfma_f32_32x32x16_bf16(pa1, PK(l1, h1), od, 0, 0, 0);
  od = __builtin_amdgcn_mfma_f32_32x32x16_bf16(pa2, PK(l2, h2), od, 0, 0, 0);
  od = __builtin_amdgcn_mfma_f32_32x32x16_bf16(pa3, PK(l3, h3), od, 0, 0, 0);
#undef PK
}
__device__ __forceinline__ void pv_d0(f32x16* o, int vb, bf16x8 pa0, bf16x8 pa1, bf16x8 pa2, bf16x8 pa3) {
  pv_one<0>(o[0], vb, pa0, pa1, pa2, pa3); pv_one<1>(o[1], vb, pa0, pa1, pa2, pa3); pv_one<2>(o[2], vb, pa0, pa1, pa2, pa3); pv_one<3>(o[3], vb, pa0, pa1, pa2, pa3);
}
__device__ __forceinline__ void store_o(float* p, float v) { *p = v; }
__device__ __forceinline__ void store_o(bf16* p, float v) { *p = __float2bfloat16(v); }

template <int DQK, typename TO>
__device__ __forceinline__ void attn_dense_body(const bf16* __restrict__ Qb, int ldq, const bf16* __restrict__ Kh, int ldk, const bf16* __restrict__ Vh, int ldv,
                                                TO* __restrict__ Ob, int ldo, int seq, char* lds) {
  const int tid = fresh_tid(), wid = tid >> 6, lane = tid & 63, r32 = lane & 31, hi = lane >> 5;
  bf16* V_lds = (bf16*)lds; bf16* K_lds = (bf16*)(lds + 2 * SHM_V);
  float* ws = (float*)(lds + 2 * SHM_V + 2 * SHM_K) + wid * 64; float* li_l = ws; float* al_l = ws + 32;
  float m_reg = -1e30f, l_reg = 0; f32x16 o[4] = {}; bf16x8 qr[DQK / 16];
  const bf16* Qw = Qb + (long)(wid * QBLK + r32) * ldq + hi * 8;
#pragma unroll
  for (int d0 = 0; d0 < DQK / 16; ++d0) qr[d0] = *reinterpret_cast<const bf16x8*>(Qw + d0 * 16);
  const int sr = tid >> 4, sc = (tid & 15) * 8, vst0 = v_st(sr, sc), vst1 = v_st(32 + sr, sc);
  const int kr = (DQK == 128) ? sr : (tid >> 3), kc = (DQK == 128) ? sc : (tid & 7) * 8;
  const int vb0 = (int)(uintptr_t)V_lds + v_rd_base(lane);
  struct { bf16x8 vs0, vs1, ks0, ks1; } sr_[2];
#define SLOAD(i, k0) do { sr_[i].vs0 = *reinterpret_cast<const bf16x8*>(&Vh[(long)((k0) + sr) * ldv + sc]); sr_[i].vs1 = *reinterpret_cast<const bf16x8*>(&Vh[(long)((k0) + 32 + sr) * ldv + sc]); \
    sr_[i].ks0 = *reinterpret_cast<const bf16x8*>(&Kh[(long)((k0) + kr) * ldk + kc]); \
    if constexpr (DQK == 128) sr_[i].ks1 = *reinterpret_cast<const bf16x8*>(&Kh[(long)((k0) + 32 + kr) * ldk + kc]); } while (0)
#define SWRITE(b, i) do { *(bf16x8*)((char*)V_lds + (b) * SHM_V + vst0) = sr_[i].vs0;          \
    *(bf16x8*)((char*)V_lds + (b) * SHM_V + vst1) = sr_[i].vs1; int kcb = kc * 2;               \
    if constexpr (DQK == 128) { *(bf16x8*)((char*)K_lds + (b) * SHM_K + KSWZ(kr, kcb)) = sr_[i].ks0;                       \
      *(bf16x8*)((char*)K_lds + (b) * SHM_K + KSWZ(32 + kr, kcb)) = sr_[i].ks1; }               \
    else { *(bf16x8*)((char*)K_lds + (b) * SHM_K + KSWZ64(kr, kcb)) = sr_[i].ks0; } } while (0)
#define SWAIT() do { if constexpr (DQK == 128) asm volatile("s_waitcnt vmcnt(4)" ::: "memory"); else asm volatile("s_waitcnt vmcnt(3)" ::: "memory"); } while (0)
#define RESC(a) do { if (__any((a) < 1.f)) { if (hi == 0) al_l[r32] = (a); asm volatile("s_waitcnt lgkmcnt(0)" ::: "memory"); \
    _Pragma("unroll") for (int d = 0; d < 4; ++d) _Pragma("unroll") for (int r = 0; r < 16; ++r) o[d][r] *= al_l[crow(r, hi)]; } } while (0)
  f32x16 pA0, pA1, pB0, pB1; float mnA, mnB, alA, alB; bf16x8 pa0, pa1, pa2, pa3; const int NT = seq / KVBLK;
  constexpr int SE = 0, SO = 1;
  SLOAD(SE, 0); asm volatile("s_waitcnt vmcnt(0)" ::: "memory"); SWRITE(0, SE); __syncthreads();
  qkt<DQK>(pA0, pA1, K_lds, qr, r32, hi); partialSM<DQK>(pA0, pA1, m_reg, mnA, alA);
  SLOAD(SO, KVBLK); if (2 < NT) SLOAD(SE, 2 * KVBLK);
  if (2 < NT) { SWAIT(); } else { asm volatile("s_waitcnt vmcnt(0)" ::: "memory"); }
  SWRITE(1, SO); __syncthreads();
  for (int j = 1; j + 1 < NT; j += 2) {
    SBAR(); qkt<DQK>(pB0, pB1, (bf16*)((char*)K_lds + SHM_K), qr, r32, hi);
    finishSM(pA0, pA1, alA, l_reg, pa0, pa1, pa2, pa3); SBAR();
    SLOAD(SO, (j + 2) * KVBLK); SBAR();
    pv_d0(o, vb0, pa0, pa1, pa2, pa3); partialSM<DQK>(pB0, pB1, m_reg, mnB, alB);
    __syncthreads(); SWAIT(); SWRITE(0, SE);
    RESC(alB); __syncthreads();
    SBAR(); qkt<DQK>(pA0, pA1, K_lds, qr, r32, hi);
    finishSM(pB0, pB1, alB, l_reg, pa0, pa1, pa2, pa3); SBAR();
    if (j + 3 < NT) SLOAD(SE, (j + 3) * KVBLK); SBAR();
    pv_d0(o, vb0 + (int)SHM_V, pa0, pa1, pa2, pa3); partialSM<DQK>(pA0, pA1, m_reg, mnA, alA);
    __syncthreads(); if (j + 3 < NT) { SWAIT(); } else { asm volatile("s_waitcnt vmcnt(0)" ::: "memory"); } SWRITE(1, SO);
    RESC(alA); __syncthreads();
  }
  SBAR(); qkt<DQK>(pB0, pB1, (bf16*)((char*)K_lds + SHM_K), qr, r32, hi);
  finishSM(pA0, pA1, alA, l_reg, pa0, pa1, pa2, pa3); SBAR();
  pv_d0(o, vb0, pa0, pa1, pa2, pa3); partialSM<DQK>(pB0, pB1, m_reg, mnB, alB);
  __syncthreads(); RESC(alB);
  finishSM(pB0, pB1, alB, l_reg, pa0, pa1, pa2, pa3); SBAR();
  pv_d0(o, vb0 + (int)SHM_V, pa0, pa1, pa2, pa3);
  if (hi == 0) li_l[r32] = l_reg; asm volatile("s_waitcnt lgkmcnt(0)" ::: "memory");
  float rli[16];
#pragma unroll
  for (int r = 0; r < 16; ++r) rli[r] = __builtin_amdgcn_rcpf(li_l[crow(r, hi)]);
  TO* Ow = Ob + (long)(wid * QBLK) * ldo;
#pragma unroll
  for (int r = 0; r < 16; ++r) { int orow = crow(r, hi);
#pragma unroll
    for (int d0 = 0; d0 < 4; ++d0) store_o(&Ow[(long)orow * ldo + d0 * 32 + r32], o[d0][r] * rli[r]); }
  __syncthreads();
#undef SLOAD
#undef SWRITE
#undef SWAIT
#undef RESC
}
#undef KSWZ
#undef KSWZ64
#undef SBAR
}
namespace cg = cooperative_groups;
#define PROBE 0
#define LAS __attribute__((address_space(3)))
typedef unsigned short bf16_t;
typedef float f32x4 __attribute__((ext_vector_type(4)));
typedef float f32x2 __attribute__((ext_vector_type(2)));
typedef unsigned u32x4 __attribute__((ext_vector_type(4)));
typedef unsigned u32x2 __attribute__((ext_vector_type(2)));

constexpr int NWAVES = 8, NTHREADS = 512;
constexpr int DM = 2048, DFF = 5504, MTOK = 8192, NCTX = 4096;
constexpr int NMOD = 9 * DM;
constexpr int NQKV_A = 3072, NQKV_B = 6144;
constexpr int KVROWS = 4096 + 2 * 2304;
constexpr float LN_EPS = 1e-6f;
constexpr float ALPHA = 1.4142135623730951f;
constexpr float LAM_INIT = 0.35550906759f;
constexpr int LDS_BYTES = 147456;

constexpr size_t al256(size_t x) { return (x + 255) / 256 * 256; }
constexpr size_t WS_BAR = 0, BAR_BYTES = 16384;
constexpr size_t WS_MOD = BAR_BYTES;
constexpr size_t WS_WIN = al256(WS_MOD + (size_t)2 * 3 * NMOD * 4);
constexpr size_t SZ_WIN = (size_t)2 * DFF * DM * 2;
constexpr size_t WS_WOUT = WS_WIN + 4 * SZ_WIN;
constexpr size_t SZ_WOUT = (size_t)DM * DFF * 2;
constexpr size_t WS_WQA = WS_WOUT + 4 * SZ_WOUT;
constexpr size_t WS_WQB = WS_WQA + (size_t)NQKV_A * DM * 2;
constexpr size_t WS_WOA = WS_WQB + (size_t)NQKV_B * DM * 2;
constexpr size_t WS_WOB = WS_WOA + (size_t)DM * DM * 2;
constexpr size_t WS_H = WS_WOB + (size_t)DM * DM * 2;
constexpr size_t WS_ACT = WS_H + (size_t)MTOK * DM * 2;
constexpr size_t WS_QKV = WS_ACT + (size_t)MTOK * DFF * 2;
constexpr size_t WS_KA = WS_QKV + (size_t)MTOK * NQKV_B * 2;
constexpr size_t WS_VA = WS_KA + (size_t)KVROWS * 512 * 2;
constexpr size_t WS_KB = WS_VA + (size_t)KVROWS * 512 * 2;
constexpr size_t WS_VB = WS_KB + (size_t)KVROWS * 2048 * 2;
constexpr size_t WS_O = WS_VB + (size_t)KVROWS * 2048 * 2;
constexpr size_t WS_OT = WS_O + (size_t)MTOK * DM * 2;
constexpr size_t WS_END = WS_OT + (size_t)MTOK * 4096 * 4;

constexpr size_t OUT_X = 0, OUT_NAK = (size_t)MTOK * DM, OUT_NAV = OUT_NAK + (size_t)NCTX * 512, OUT_NBK = OUT_NAV + (size_t)NCTX * 512, OUT_NBV = OUT_NBK + (size_t)NCTX * 2048;

__device__ __forceinline__ float wave_sum(float v) {
#pragma unroll
    for (int o = 1; o < 64; o <<= 1) v += __shfl_xor(v, o);
    return v;
}
__device__ __forceinline__ unsigned pk_bf16(float lo, float hi) { return pg8::cvt_pk_bf16(lo, hi); }
__device__ __forceinline__ float bf2f(bf16_t b) { return __uint_as_float((unsigned)b << 16); }
__device__ __forceinline__ bf16_t f2bf(float f) { return (bf16_t)(pk_bf16(f, 0.f) & 0xffffu); }
#define LDS_WAIT() asm volatile("s_waitcnt lgkmcnt(0)" ::: "memory")

#define XB_TMO      128
#define XB_XCNT(j)  (256  + 64 * (j))
#define XB_XSUB(j)  (1280 + 64 * (j))
#define XB_XGEN(j)  (2304 + 64 * (j))
#define XB_TOP      3328
#define XB_TOPGEN   3392
#define XCD_BAR_WORDS 3456
#define XB_SPIN_CAP (1u << 18)

__device__ __forceinline__ unsigned xb_ld(unsigned* p)              { return __hip_atomic_load(p, __ATOMIC_RELAXED, __HIP_MEMORY_SCOPE_AGENT); }
__device__ __forceinline__ unsigned xb_add(unsigned* p, unsigned v) { return __hip_atomic_fetch_add(p, v, __ATOMIC_RELAXED, __HIP_MEMORY_SCOPE_AGENT); }
__device__ __forceinline__ unsigned xb_xcc_id() { return (unsigned)__builtin_amdgcn_s_getreg((3 << 11) | 20) & 0xFu; }
#define XB_SPIN(cond, bar) do { unsigned _sp = 0; while (cond) { __builtin_amdgcn_s_sleep(1); \
    if ((++_sp & 255u) == 0u) { if (xb_ld(&(bar)[XB_TMO])) break; if (_sp > XB_SPIN_CAP) { atomicAdd(&(bar)[XB_TMO], 1u); break; } } } } while (0)

struct XcdBarrier {
    unsigned* bar; unsigned x;
    volatile LAS unsigned* st;
};

__device__ __forceinline__ XcdBarrier xcd_barrier_post(unsigned* bar, volatile LAS unsigned* st) {
    XcdBarrier b; b.bar = bar; b.x = xb_xcc_id(); b.st = st;
    if (threadIdx.x == 0) (void)xb_add(&bar[XB_XCNT(b.x)], 1u);
    return b;
}
__device__ __forceinline__ void xcd_barrier_complete(unsigned* bar, unsigned x, unsigned& nloc, unsigned& nx) {
    const unsigned G = gridDim.x * gridDim.y * gridDim.z;
    unsigned sum, cnt, mine, sp = 0u;
    for (;;) {
        sum = 0u; cnt = 0u; mine = 0u;
#pragma unroll
        for (unsigned j = 0; j < 16; ++j) { const unsigned c = xb_ld(&bar[XB_XCNT(j)]); sum += c; cnt += (c > 0u) ? 1u : 0u; mine = (j == x) ? c : mine; }
        if (sum == G) break;
        __builtin_amdgcn_s_sleep(1);
        if ((++sp & 255u) == 0u) { if (xb_ld(&bar[XB_TMO])) break; if (sp > XB_SPIN_CAP) { atomicAdd(&bar[XB_TMO], 1u); break; } }
    }
    nloc = mine > 0u ? mine : 1u; nx = cnt > 0u ? cnt : 1u;
}

__device__ __forceinline__ void xcd_barrier(const XcdBarrier& b) {
    asm volatile("s_waitcnt vmcnt(0)" ::: "memory");
    __syncthreads();
    if (threadIdx.x == 0) {
        unsigned* bar = b.bar;
        __builtin_amdgcn_s_waitcnt(0);
        unsigned nloc = b.st[0], nx = b.st[1];
        if (nloc == 0u) { xcd_barrier_complete(bar, b.x, nloc, nx); b.st[0] = nloc; b.st[1] = nx; }
        const unsigned old = xb_add(&bar[XB_XSUB(b.x)], 1u);
        const unsigned gen = old / nloc;
        if (old + 1u == (gen + 1u) * nloc) {
            __builtin_amdgcn_fence(__ATOMIC_RELEASE, "agent");
            asm volatile("s_waitcnt vmcnt(0)" ::: "memory");
            const unsigned og = xb_add(&bar[XB_TOP], 1u);
            const unsigned tg = og / nx;
            if (og + 1u == (tg + 1u) * nx) xb_add(&bar[XB_TOPGEN], 1u);
            else XB_SPIN(xb_ld(&bar[XB_TOPGEN]) == tg, bar);
            __builtin_amdgcn_fence(__ATOMIC_ACQUIRE, "agent");
            xb_add(&bar[XB_XGEN(b.x)], 1u);
            asm volatile("s_waitcnt vmcnt(0)" ::: "memory");
        } else {
            XB_SPIN(xb_ld(&bar[XB_XGEN(b.x)]) == gen, bar);
            __builtin_amdgcn_fence(__ATOMIC_ACQUIRE, "agent");
            asm volatile("s_waitcnt vmcnt(0)" ::: "memory");
        }
    }
    __syncthreads();
}

struct Args { const float* in[22]; float* out; unsigned char* ws; int ph_lo, ph_hi; };

__device__ __forceinline__ void p0_gemv(const Args& a, LAS unsigned char* lds, int G) {
    const int tid = fresh_tid(), lane = tid & 63, wave = tid >> 6;
    LAS float* sc = (LAS float*)lds;
    LAS float* red = sc + 3 * DM;
    const float* c = a.in[6]; const float* cctx = a.in[7];
    for (int i = tid; i < 3 * DM; i += NTHREADS) { const int ci = i / DM, k = i % DM; const float v = ci == 0 ? cctx[k] : c[(ci - 1) * DM + k]; sc[i] = pg8::silu_f(v); }
    __syncthreads();
    float* MOD = (float*)(a.ws + WS_MOD);
    for (int item = blockIdx.x; item < 2 * 144; item += G) {
        const int l = item / 144, cgp = item % 144;
        const float* W = a.in[8] + (size_t)l * DM * NMOD + cgp * 128 + 2 * lane;
        f32x2 acc0 = {0.f, 0.f}, acc1 = {0.f, 0.f}, acc2 = {0.f, 0.f};
        const int kb = wave * 256;
        for (int k = kb; k < kb + 256; k += 8) {
            f32x2 w[8];
#pragma unroll
            for (int i = 0; i < 8; ++i) w[i] = *(const f32x2*)(W + (size_t)(k + i) * NMOD);
#pragma unroll
            for (int i = 0; i < 8; ++i) { acc0 += w[i] * sc[k + i]; acc1 += w[i] * sc[DM + k + i]; acc2 += w[i] * sc[2 * DM + k + i]; }
        }
        *(LAS f32x2*)(red + (wave * 3 + 0) * 128 + 2 * lane) = acc0;
        *(LAS f32x2*)(red + (wave * 3 + 1) * 128 + 2 * lane) = acc1;
        *(LAS f32x2*)(red + (wave * 3 + 2) * 128 + 2 * lane) = acc2;
        __syncthreads();
        if (tid < 384) { const int ci = tid >> 7, j = tid & 127; float s = 0.f;
#pragma unroll
            for (int w = 0; w < 8; ++w) s += red[(w * 3 + ci) * 128 + j];
            MOD[(size_t)(l * 3 + ci) * NMOD + cgp * 128 + j] = s + a.in[9][(size_t)l * NMOD + cgp * 128 + j]; }
        __syncthreads();
    }
}
__device__ __forceinline__ void p0_transpose_tile(const float* W, int K, int N, bf16_t* WT, int k0, int n0, int rb, LAS float* scr, int lane) {
    const int kk0 = lane >> 4, c4 = (lane & 15) * 4;
    f32x4 v[16];
#pragma unroll
    for (int i = 0; i < 16; ++i) v[i] = *(const f32x4*)(W + (size_t)(k0 + 4 * i + kk0) * N + n0 + c4);
#pragma unroll
    for (int i = 0; i < 16; ++i) { LAS float* d = scr + (4 * i + kk0) * 65 + c4; d[0] = v[i].x; d[1] = v[i].y; d[2] = v[i].z; d[3] = v[i].w; }
    LDS_WAIT();
    const int c = lane & 7;
#pragma unroll
    for (int j = 0; j < 8; ++j) { const int n = (lane >> 3) + 8 * j; const LAS float* s = scr + (8 * c) * 65 + n;
        u32x4 o; o.x = pk_bf16(s[0 * 65], s[1 * 65]); o.y = pk_bf16(s[2 * 65], s[3 * 65]); o.z = pk_bf16(s[4 * 65], s[5 * 65]); o.w = pk_bf16(s[6 * 65], s[7 * 65]);
        *(u32x4*)(WT + (size_t)(rb + n) * K + k0 + 8 * c) = o; }
    LDS_WAIT();
}
constexpr int I_IN = 32 * 172, I_OUT = 86 * 32, I_QA = 32 * 48, I_QB = 32 * 96, I_O = 32 * 32;
constexpr int IT_IN0 = 0, IT_OUT0 = 4 * I_IN, IT_QA = IT_OUT0 + 4 * I_OUT, IT_QB = IT_QA + I_QA, IT_OA = IT_QB + I_QB, IT_OB = IT_OA + I_O, IT_END = IT_OB + I_O;
__device__ __forceinline__ void p0_convert_item(const Args& a, int it, LAS float* scr, int lane) {
    int r = it;
    if (r < 4 * I_IN) { const int w = r / I_IN; r -= w * I_IN; const int kb = r / 172, nb = r % 172, n0 = nb * 64;
        const int f = n0 < DFF ? n0 : n0 - DFF; const int rb = 256 * (f >> 7) + (f & 127) + (n0 < DFF ? 0 : 128);
        p0_transpose_tile(a.in[12] + (size_t)w * DM * 2 * DFF, DM, 2 * DFF, (bf16_t*)(a.ws + WS_WIN + w * SZ_WIN), kb * 64, n0, rb, scr, lane); return; }
    r -= 4 * I_IN;
    if (r < 4 * I_OUT) { const int w = r / I_OUT; r -= w * I_OUT; const int kb = r / 32, nb = r % 32;
        p0_transpose_tile(a.in[13] + (size_t)w * DFF * DM, DFF, DM, (bf16_t*)(a.ws + WS_WOUT + w * SZ_WOUT), kb * 64, nb * 64, nb * 64, scr, lane); return; }
    r -= 4 * I_OUT;
    if (r < I_QA) { const int kb = r / 48, nb = r % 48; p0_transpose_tile(a.in[14], DM, NQKV_A, (bf16_t*)(a.ws + WS_WQA), kb * 64, nb * 64, nb * 64, scr, lane); return; }
    r -= I_QA;
    if (r < I_QB) { const int kb = r / 96, nb = r % 96; p0_transpose_tile(a.in[18], DM, NQKV_B, (bf16_t*)(a.ws + WS_WQB), kb * 64, nb * 64, nb * 64, scr, lane); return; }
    r -= I_QB;
    if (r < I_O) { const int kb = r / 32, nb = r % 32; p0_transpose_tile(a.in[17], DM, DM, (bf16_t*)(a.ws + WS_WOA), kb * 64, nb * 64, nb * 64, scr, lane); return; }
    r -= I_O;
    { const int kb = r / 32, nb = r % 32; p0_transpose_tile(a.in[21], DM, DM, (bf16_t*)(a.ws + WS_WOB), kb * 64, nb * 64, nb * 64, scr, lane); }
}
__device__ __forceinline__ void p0_convert_ranges(const Args& a, LAS unsigned char* lds, int worker, int nworkers, int lo0, int n0, int lo1, int n1, int lo2, int n2, int lo3, int n3) {
    const int tid = fresh_tid(), lane = tid & 63, wave = tid >> 6;
    LAS float* scr = (LAS float*)lds + wave * (64 * 65);
    const int total = n0 + n1 + n2 + n3;
    for (int v = worker * NWAVES + wave; v < total; v += nworkers * NWAVES) {
        const int it = v < n0 ? lo0 + v : (v < n0 + n1 ? lo1 + (v - n0) : (v < n0 + n1 + n2 ? lo2 + (v - n0 - n1) : lo3 + (v - n0 - n1 - n2)));
        p0_convert_item(a, it, scr, lane);
    }
}
__device__ __forceinline__ void p0_caches(const Args& a, int G) {
    const int tid = fresh_tid();
    const size_t gt = (size_t)blockIdx.x * NTHREADS + tid, NGT = (size_t)G * NTHREADS;
    constexpr size_t NA8 = (size_t)2 * 256 * 512 / 8, NB8 = (size_t)2 * 256 * 2048 / 8;
    for (size_t i = gt; i < 2 * NA8 + 2 * NB8; i += NGT) {
        const float* src; bf16_t* dst; size_t j; int wdt;
        if (i < NA8) { j = i; src = a.in[2]; dst = (bf16_t*)(a.ws + WS_KA); wdt = 512; }
        else if (i < 2 * NA8) { j = i - NA8; src = a.in[3]; dst = (bf16_t*)(a.ws + WS_VA); wdt = 512; }
        else if (i < 2 * NA8 + NB8) { j = i - 2 * NA8; src = a.in[4]; dst = (bf16_t*)(a.ws + WS_KB); wdt = 2048; }
        else { j = i - 2 * NA8 - NB8; src = a.in[5]; dst = (bf16_t*)(a.ws + WS_VB); wdt = 2048; }
        const size_t e = j * 8, row = e / wdt, col = e % wdt, b = row >> 8, t = row & 255;
        const f32x4 x0 = *(const f32x4*)(src + e), x1 = *(const f32x4*)(src + e + 4);
        u32x4 o; o.x = pk_bf16(x0.x, x0.y); o.y = pk_bf16(x0.z, x0.w); o.z = pk_bf16(x1.x, x1.y); o.w = pk_bf16(x1.z, x1.w);
        *(u32x4*)(dst + (size_t)(4096 + b * 2304 + t) * wdt + col) = o;
    }
}

__device__ __forceinline__ int cidx_of(int row) { return row < NCTX ? 0 : 1 + ((row - NCTX) >> 11); }
__device__ __forceinline__ void ln_phase(const Args& a, bool first, const float* g, const float* bta, const float* modp, int G) {
    const int tid = fresh_tid(), lane = tid & 63, wave = tid >> 6;
    const int gw = blockIdx.x * NWAVES + wave, NGW = G * NWAVES;
    float* X = a.out + OUT_X; bf16_t* H = (bf16_t*)(a.ws + WS_H);
    for (int row = gw; row < MTOK; row += NGW) {
        const float* src = first ? (row < NCTX ? a.in[0] + (size_t)row * DM : a.in[1] + (size_t)(row - NCTX) * DM) : X + (size_t)row * DM;
        f32x4 v[8];
#pragma unroll
        for (int j = 0; j < 8; ++j) v[j] = *(const f32x4*)(src + 4 * lane + 256 * j);
        if (!first) {
            float s = 0.f;
#pragma unroll
            for (int j = 0; j < 8; ++j) s += (v[j].x + v[j].y) + (v[j].z + v[j].w);
            const float mean = wave_sum(s) * (1.f / DM); float s2 = 0.f;
#pragma unroll
            for (int j = 0; j < 8; ++j) { v[j] = v[j] - mean; s2 += (v[j].x * v[j].x + v[j].y * v[j].y) + (v[j].z * v[j].z + v[j].w * v[j].w); }
            const float rstd = 1.0f / sqrtf(wave_sum(s2) * (1.f / DM) + LN_EPS);
#pragma unroll
            for (int j = 0; j < 8; ++j) { const f32x4 gg = *(const f32x4*)(g + 4 * lane + 256 * j), bb = *(const f32x4*)(bta + 4 * lane + 256 * j); v[j] = v[j] * rstd * gg + bb; }
        }
#pragma unroll
        for (int j = 0; j < 8; ++j) *(f32x4*)(X + (size_t)row * DM + 4 * lane + 256 * j) = v[j];
        if (modp) {
            const float* mp = modp + (size_t)cidx_of(row) * NMOD;
#pragma unroll
            for (int j = 0; j < 8; ++j) { const f32x4 sh = *(const f32x4*)(mp + 4 * lane + 256 * j), scl = *(const f32x4*)(mp + DM + 4 * lane + 256 * j);
                const f32x4 h = v[j] * (scl + 1.0f) + sh; u32x2 o; o.x = pk_bf16(h.x, h.y); o.y = pk_bf16(h.z, h.w);
                *(u32x2*)(H + (size_t)row * DM + 4 * lane + 256 * j) = o; }
        }
    }
}
__device__ __forceinline__ void normrope_a(const Args& a, int G) {
    const int tid = fresh_tid(), lane = tid & 63, wave = tid >> 6;
    const int gw = blockIdx.x * NWAVES + wave, NGW = G * NWAVES;
    bf16_t* QKV = (bf16_t*)(a.ws + WS_QKV); bf16_t* KA = (bf16_t*)(a.ws + WS_KA); bf16_t* VA = (bf16_t*)(a.ws + WS_VA);
    const float qn0 = a.in[15][lane], qn1 = a.in[15][64 + lane], kn0 = a.in[16][lane], kn1 = a.in[16][64 + lane];
    const float inv = __builtin_amdgcn_exp2f(-13.287712379549449f * (float)(lane & 31) * (1.0f / 32.0f));
    for (int row = gw; row < MTOK; row += NGW) {
        const bool lat = row >= NCTX; const int s = (row - NCTX) & 2047, b = (row - NCTX) >> 11;
        float cs = 1.f, sn = 0.f;
        if (lat) { const float pos = (float)(lane < 32 ? (s >> 6) : (s & 63)); const float ang = pos * inv; cs = __cosf(ang); sn = __sinf(ang); }
        const int kvrow = lat ? 4096 + b * 2304 + 256 + s : row;
        bf16_t* src = QKV + (size_t)row * NQKV_A;
#pragma unroll 4
        for (int j = 0; j < 20; ++j) {
            const float x1 = bf2f(src[j * 128 + lane]), x2 = bf2f(src[j * 128 + 64 + lane]);
            const float rstd = 1.0f / sqrtf(wave_sum(x1 * x1 + x2 * x2) * (1.f / 128.f) + LN_EPS);
            const float y1 = x1 * rstd * (j < 16 ? qn0 : kn0), y2 = x2 * rstd * (j < 16 ? qn1 : kn1);
            const float o1 = y1 * cs - y2 * sn, o2 = y2 * cs + y1 * sn;
            if (j < 16) { src[j * 128 + lane] = f2bf(o1); src[j * 128 + 64 + lane] = f2bf(o2); }
            else { bf16_t* kd = KA + (size_t)kvrow * 512 + (j - 16) * 128; kd[lane] = f2bf(o1); kd[64 + lane] = f2bf(o2);
                if (!lat) { float* od = a.out + OUT_NAK + (size_t)row * 512 + (j - 16) * 128; od[lane] = o1; od[64 + lane] = o2; } }
        }
        const u32x4 vv = *(const u32x4*)(src + 2560 + lane * 8);
        *(u32x4*)(VA + (size_t)kvrow * 512 + lane * 8) = vv;
        if (!lat) { float* od = a.out + OUT_NAV + (size_t)row * 512 + lane * 8;
            f32x4 lo = {__uint_as_float(vv.x << 16), __uint_as_float(vv.x & 0xffff0000u), __uint_as_float(vv.y << 16), __uint_as_float(vv.y & 0xffff0000u)};
            f32x4 hi = {__uint_as_float(vv.z << 16), __uint_as_float(vv.z & 0xffff0000u), __uint_as_float(vv.w << 16), __uint_as_float(vv.w & 0xffff0000u)};
            *(f32x4*)od = lo; *(f32x4*)(od + 4) = hi; }
    }
}
__device__ __forceinline__ void normrope_b(const Args& a, int G) {
    const int tid = fresh_tid(), lane = tid & 63, wave = tid >> 6;
    const int gw = blockIdx.x * NWAVES + wave, NGW = G * NWAVES;
    bf16_t* QKV = (bf16_t*)(a.ws + WS_QKV); bf16_t* KB = (bf16_t*)(a.ws + WS_KB); bf16_t* VB = (bf16_t*)(a.ws + WS_VB);
    const int i32 = lane & 31, vsel = lane >> 5;
    const float inv = __builtin_amdgcn_exp2f(-13.287712379549449f * (float)(i32 & 15) * (1.0f / 16.0f));
    for (int row = gw; row < MTOK; row += NGW) {
        const bool lat = row >= NCTX; const int s = (row - NCTX) & 2047, b = (row - NCTX) >> 11;
        const int kvrow = lat ? 4096 + b * 2304 + 256 + s : row;
        bf16_t* src = QKV + (size_t)row * NQKV_B;
        if (lat) {
            const float pos = (float)(i32 < 16 ? (s >> 6) : (s & 63)); const float ang = pos * inv; const float cs = __cosf(ang), sn = __sinf(ang);
#pragma unroll 4
            for (int it = 0; it < 32; ++it) {
                const int vec = 2 * it + vsel; bf16_t* p = src + vec * 64;
                const float x1 = bf2f(p[i32]), x2 = bf2f(p[32 + i32]);
                const float o1 = x1 * cs - x2 * sn, o2 = x2 * cs + x1 * sn;
                bf16_t* d = vec < 32 ? p : KB + (size_t)kvrow * 2048 + (vec - 32) * 64;
                d[i32] = f2bf(o1); d[32 + i32] = f2bf(o2);
            }
#pragma unroll
            for (int j = 0; j < 4; ++j) *(u32x4*)(VB + (size_t)kvrow * 2048 + j * 512 + lane * 8) = *(const u32x4*)(src + 4096 + j * 512 + lane * 8);
        } else {
#pragma unroll
            for (int j = 0; j < 8; ++j) {
                const u32x4 vv = *(const u32x4*)(src + 2048 + j * 512 + lane * 8);
                bf16_t* dst = (j < 4 ? KB : VB) + (size_t)kvrow * 2048 + (j & 3) * 512 + lane * 8;
                *(u32x4*)dst = vv;
                float* od = a.out + (j < 4 ? OUT_NBK : OUT_NBV) + (size_t)row * 2048 + (j & 3) * 512 + lane * 8;
                f32x4 lo = {__uint_as_float(vv.x << 16), __uint_as_float(vv.x & 0xffff0000u), __uint_as_float(vv.y << 16), __uint_as_float(vv.y & 0xffff0000u)};
                f32x4 hi = {__uint_as_float(vv.z << 16), __uint_as_float(vv.z & 0xffff0000u), __uint_as_float(vv.w << 16), __uint_as_float(vv.w & 0xffff0000u)};
                *(f32x4*)od = lo; *(f32x4*)(od + 4) = hi;
            }
        }
    }
}
__device__ __forceinline__ void combine_b(const Args& a, int G) {
    const int tid = fresh_tid(), lane = tid & 63, wave = tid >> 6;
    const int gw = blockIdx.x * NWAVES + wave, NGW = G * NWAVES;
    const float* lp = a.in[19];
    const float lam = __expf(wave_sum(lp[lane] * lp[64 + lane])) - __expf(wave_sum(lp[128 + lane] * lp[192 + lane])) + LAM_INIT;
    const float g0 = a.in[20][lane] * (1.0f - LAM_INIT), g1 = a.in[20][64 + lane] * (1.0f - LAM_INIT);
    const float* OT = (const float*)(a.ws + WS_OT); bf16_t* O = (bf16_t*)(a.ws + WS_O);
    for (int row = gw; row < MTOK; row += NGW) {
#pragma unroll 4
        for (int h = 0; h < 16; ++h) {
            const float* p1 = OT + (size_t)row * 4096 + (2 * h) * 128; const float* p2 = p1 + 128;
            const float oa = p1[lane] - lam * p2[lane], ob = p1[64 + lane] - lam * p2[64 + lane];
            const float rstd = 1.0f / sqrtf(wave_sum(oa * oa + ob * ob) * (1.f / 128.f) + LN_EPS);
            O[(size_t)row * DM + h * 128 + lane] = f2bf(oa * rstd * g0); O[(size_t)row * DM + h * 128 + 64 + lane] = f2bf(ob * rstd * g1);
        }
    }
}
__device__ __forceinline__ void attn_a(const Args& a, char* lds, int vcu, int G) {
    const att::bf16* QKV = (const att::bf16*)(a.ws + WS_QKV); const att::bf16* KA = (const att::bf16*)(a.ws + WS_KA); const att::bf16* VA = (const att::bf16*)(a.ws + WS_VA);
    att::bf16* O = (att::bf16*)(a.ws + WS_O);
    for (int u = vcu; u < 512; u += G) {
        if (u < 256) { const int b = u >> 7, h = (u >> 3) & 15, qt = u & 7; const size_t qrow = 4096 + (size_t)b * 2048 + qt * 256, krow = 4096 + (size_t)b * 2304;
            att::attn_dense_body<128, att::bf16>(QKV + qrow * NQKV_A + h * 128, NQKV_A, KA + krow * 512 + (h >> 2) * 128, 512, VA + krow * 512 + (h >> 2) * 128, 512, O + qrow * DM + h * 128, DM, 2304, lds); }
        else { const int v = u - 256, b = v >> 4, h = v & 15; const size_t qrow = (size_t)b * 256;
            att::attn_dense_body<128, att::bf16>(QKV + qrow * NQKV_A + h * 128, NQKV_A, KA + qrow * 512 + (h >> 2) * 128, 512, VA + qrow * 512 + (h >> 2) * 128, 512, O + qrow * DM + h * 128, DM, 256, lds); }
    }
}
__device__ __forceinline__ void attn_b(const Args& a, char* lds, int vcu, int G) {
    const att::bf16* QKV = (const att::bf16*)(a.ws + WS_QKV); const att::bf16* KB = (const att::bf16*)(a.ws + WS_KB); const att::bf16* VB = (const att::bf16*)(a.ws + WS_VB);
    float* OT = (float*)(a.ws + WS_OT);
    for (int u = vcu; u < 1024; u += G) {
        if (u < 512) { const int b = u >> 8, hp = (u >> 3) & 31, qt = u & 7; const size_t qrow = 4096 + (size_t)b * 2048 + qt * 256, krow = 4096 + (size_t)b * 2304;
            att::attn_dense_body<64, float>(QKV + qrow * NQKV_B + hp * 64, NQKV_B, KB + krow * 2048 + hp * 64, 2048, VB + krow * 2048 + (hp >> 1) * 128, 2048, OT + qrow * 4096 + hp * 128, 4096, 2304, lds); }
        else { const int v = u - 512, b = v >> 5, hp = v & 31; const size_t qrow = (size_t)b * 256;
            att::attn_dense_body<64, float>(QKV + qrow * NQKV_B + hp * 64, NQKV_B, KB + qrow * 2048 + hp * 64, 2048, VB + qrow * 2048 + (hp >> 1) * 128, 2048, OT + qrow * 4096 + hp * 128, 4096, 256, lds); }
    }
}

__global__ void __launch_bounds__(NTHREADS, 2) mega_fwd(Args a) {
    extern __shared__ __attribute__((aligned(16))) unsigned char lds_raw[];
    LAS unsigned char* lds = (LAS unsigned char*)lds_raw;
    cg::grid_group grid = cg::this_grid();
    const int G = gridDim.x, bx = blockIdx.x;
    const int vcu = (G % 8 == 0) ? (bx % 8) * (G / 8) + bx / 8 : bx;
    const float* MOD = (const float*)(a.ws + WS_MOD);
    volatile LAS unsigned* misc = (volatile LAS unsigned*)(lds + LDS_BYTES - 64);
    if (threadIdx.x < 16) misc[threadIdx.x] = 0u;
    __syncthreads();
    const XcdBarrier bar = xcd_barrier_post((unsigned*)(a.ws + WS_BAR), misc);
    if (a.ph_hi < 0) grid.sync();
    int ph = 0;
#define RUNN(n, ...) do { if (ph >= a.ph_lo && ph < a.ph_hi) { for (int rep_ = 0; rep_ < (n); ++rep_) { const bool PROBE_DRY = rep_ + 1 < (n); (void)PROBE_DRY; __VA_ARGS__; \
        if (ph + 1 < a.ph_hi) { xcd_barrier(bar); if (PROBE & 2) xcd_barrier(bar); } } } ++ph; } while (0)
#define RUN(...) RUNN(1, __VA_ARGS__)

    RUNN((PROBE & 1) ? 2 : 1, { p0_gemv(a, lds, G); { const bool skew = G > 64; const int wk = skew ? bx - 32 : bx; if (wk >= 0) p0_convert_ranges(a, lds, wk, skew ? G - 32 : G, IT_IN0, I_IN, 0, 0, 0, 0, 0, 0); } p0_caches(a, G); });
    RUNN((PROBE & 64) ? 2 : 1, ln_phase(a, true, nullptr, nullptr, MOD, G));
    for (int l = 0; l < 2; ++l) {
        for (int s = 0; s < 3; ++s) {
            const float* modl = MOD + (size_t)l * 3 * NMOD;
            if (s != 1) {
                const int w = l * 2 + (s >> 1);
                RUNN((PROBE & 4) ? 2 : 1, { pg8::Gemm g{(const bf16_t*)(a.ws + WS_H), (const bf16_t*)(a.ws + WS_WIN + w * SZ_WIN), MTOK, 2 * DFF, DM};
                      pg8::StaticOrder S; S.init(MTOK, 2 * DFF, G, bx);
                      pg8::EpiSwiglu E{(bf16_t*)(a.ws + WS_ACT), DFF};
                      pg8::gemm_phase<pg8::EpiSwiglu, pg8::StaticOrder, true, true>(lds, g, S, E);
                      if (!PROBE_DRY) { const int rem = (32 * 43) % G; const int wk = rem == 0 ? bx : bx - rem, nwk = rem == 0 ? G : G - rem;
                        if (wk >= 0) {
                          if (w == 0) p0_convert_ranges(a, lds, wk, nwk, IT_OUT0, I_OUT, IT_QA, I_QA, IT_OA, I_O, IT_IN0 + I_IN, I_IN);
                          else if (w == 1) p0_convert_ranges(a, lds, wk, nwk, IT_OUT0 + I_OUT, I_OUT, IT_IN0 + 2 * I_IN, I_IN, IT_QB, I_QB, 0, 0);
                          else if (w == 2) p0_convert_ranges(a, lds, wk, nwk, IT_OUT0 + 2 * I_OUT, I_OUT, IT_OB, I_O, IT_IN0 + 3 * I_IN, I_IN, 0, 0);
                          else p0_convert_ranges(a, lds, wk, nwk, IT_OUT0 + 3 * I_OUT, I_OUT, 0, 0, 0, 0, 0, 0); } } });
                RUNN((PROBE & 16) ? 2 : 1, { pg8::Gemm g{(const bf16_t*)(a.ws + WS_ACT), (const bf16_t*)(a.ws + WS_WOUT + w * SZ_WOUT), MTOK, DM, DFF};
                      pg8::StaticOrder S; S.init(MTOK, DM, G, bx);
                      pg8::EpiRes E{a.out + OUT_X, PROBE_DRY ? (float*)(a.ws + WS_OT) : a.out + OUT_X, modl + s * 3 * DM + 2 * DM, NMOD, ALPHA, 0.5f};
                      pg8::gemm_phase<pg8::EpiRes, pg8::StaticOrder, true, true>(lds, g, S, E); });
            } else {
                const int nq = l == 0 ? NQKV_A : NQKV_B;
                RUNN((PROBE & 32) ? 2 : 1, { pg8::Gemm g{(const bf16_t*)(a.ws + WS_H), (const bf16_t*)(a.ws + (l == 0 ? WS_WQA : WS_WQB)), MTOK, nq, DM};
                      pg8::StaticOrder S; S.init(MTOK, nq, G, bx);
                      pg8::EpiPlain E{(bf16_t*)(a.ws + WS_QKV), nq};
                      pg8::gemm_phase<pg8::EpiPlain, pg8::StaticOrder, true, true>(lds, g, S, E); });
                if (l == 0) {
                    RUN(normrope_a(a, G));
                    RUNN((PROBE & 8) ? 2 : 1, attn_a(a, (char*)lds_raw, vcu, G));
                } else {
                    RUN(normrope_b(a, G));
                    RUNN((PROBE & 8) ? 2 : 1, attn_b(a, (char*)lds_raw, vcu, G));
                    RUNN((PROBE & 128) ? 2 : 1, combine_b(a, G));
                }
                RUN({ pg8::Gemm g{(const bf16_t*)(a.ws + WS_O), (const bf16_t*)(a.ws + (l == 0 ? WS_WOA : WS_WOB)), MTOK, DM, DM};
                      pg8::StaticOrder S; S.init(MTOK, DM, G, bx);
                      pg8::EpiRes E{a.out + OUT_X, a.out + OUT_X, modl + s * 3 * DM + 2 * DM, NMOD, ALPHA, 1.0f};
                      pg8::gemm_phase<pg8::EpiRes, pg8::StaticOrder, true, true>(lds, g, S, E); });
            }
            const float* nmod = s < 2 ? modl + (s + 1) * 3 * DM : (l == 0 ? MOD + (size_t)3 * NMOD : nullptr);
            RUN(ln_phase(a, false, a.in[10] + (size_t)(l * 3 + s) * DM, a.in[11] + (size_t)(l * 3 + s) * DM, nmod, G));
        }
    }
#undef RUN
#undef RUNN
}
constexpr int N_PHASES = 2 + 3 + 3 + 4 + 3 + 3 + 5 + 3 + 1;

#ifndef MK_MULTI
#define MK_MULTI 0
#endif
extern "C" void kernel_launch(void* const* d_in, const int* in_sizes, int n_in, void* d_out, int out_size, void* d_ws, size_t ws_size, hipStream_t stream) {
    static int grid = 0;
    if (grid == 0) {
        if (n_in != 22 || ws_size < WS_END || out_size != (int)(OUT_NBV + (size_t)NCTX * 2048)) { fprintf(stderr, "kernel_launch: unexpected shapes (n_in %d, out %d, ws %zu need %zu)\n", n_in, out_size, ws_size, (size_t)WS_END); grid = -1; return; }
        int dev = 0, cus = 0, per_cu = 0;
        hipGetDevice(&dev); hipDeviceGetAttribute(&cus, hipDeviceAttributeMultiprocessorCount, dev);
        if (hipFuncSetAttribute((const void*)mega_fwd, hipFuncAttributeMaxDynamicSharedMemorySize, LDS_BYTES) != hipSuccess) { fprintf(stderr, "kernel_launch: hipFuncSetAttribute failed\n"); grid = -1; return; }
        if (hipOccupancyMaxActiveBlocksPerMultiprocessor(&per_cu, (const void*)mega_fwd, NTHREADS, LDS_BYTES) != hipSuccess || per_cu < 1) { fprintf(stderr, "kernel_launch: occupancy query gives %d\n", per_cu); per_cu = 1; }
        (void)hipGetLastError();
        grid = cus * 1;
    }
    if (grid < 0) return;
    if (hipMemsetAsync((char*)d_ws + WS_BAR, 0, BAR_BYTES, stream) != hipSuccess) { fprintf(stderr, "kernel_launch: memset failed\n"); return; }
    Args a{};
    for (int i = 0; i < 22; ++i) a.in[i] = (const float*)d_in[i];
    a.out = (float*)d_out; a.ws = (unsigned char*)d_ws;
#if MK_MULTI
    for (int p = 0; p < 25; ++p) { a.ph_lo = p; a.ph_hi = p + 1; hipLaunchKernelGGL(mega_fwd, dim3(grid), dim3(NTHREADS), LDS_BYTES, stream, a); }
#else
    a.ph_lo = 0; a.ph_hi = 1000;
    void* args[] = {&a};
    hipError_t e = hipLaunchCooperativeKernel((const void*)mega_fwd, dim3(grid), dim3(NTHREADS), args, LDS_BYTES, stream);
    if (e != hipSuccess) fprintf(stderr, "kernel_launch: cooperative launch failed: %s (grid %d)\n", hipGetErrorString(e), grid);
#endif
}
```
